# Optimizing an MI355X kernel written in HIP

```python
import jax, jax.numpy as jnp
from jax import lax
import numpy as np

D_MODEL = 2048
BATCH = 4
SEQ = 4096
DEPTH = 1

MEM_LEN = 256
GRID_W = 64
HEAD_DIM = 64
NA_HEADS = 16
NA_ROWS = 8
NA_COLS = 16
WIN_Q_HEADS = 16
WIN_KV_HEADS = 4
WINDOW = 128
ROT_DIM = HEAD_DIM // 4
ROPE_THETA = 500000.0
CROSS_HEADS = 4
CROSS_HEAD_DIM = 128
N_EXPERTS = 32
TOP_K = 4
D_FF = D_MODEL
SWIGLU_LIMIT = 7.0
SWIGLU_ALPHA = 1.702
EXPERT_BLOCK = 128
NORM_EPS = 1e-5
NEG_INF = -1e30

NA_WIDTH = NA_HEADS * HEAD_DIM
WIN_Q_WIDTH = WIN_Q_HEADS * HEAD_DIM
WIN_KV_WIDTH = WIN_KV_HEADS * HEAD_DIM
CROSS_WIDTH = CROSS_HEADS * CROSS_HEAD_DIM
D_IN = 3 * NA_WIDTH + WIN_Q_WIDTH + 2 * WIN_KV_WIDTH + 2 * D_MODEL

kernel_name = "hybrid_natten_swa_moe_encoder"


def _split_points():
    widths = [NA_WIDTH, NA_WIDTH, NA_WIDTH, WIN_Q_WIDTH, WIN_KV_WIDTH, WIN_KV_WIDTH, D_MODEL]
    pts, acc = [], 0
    for w in widths:
        acc += w
        pts.append(acc)
    return pts


def rmsnorm(x, g):
    x32 = x.astype(jnp.float32)
    y = x32 * lax.rsqrt(jnp.mean(x32 * x32, axis=-1, keepdims=True) + NORM_EPS)
    return (y * g.astype(jnp.float32)).astype(x.dtype)


def partial_rope(x, pos):
    half = ROT_DIM // 2
    inv = ROPE_THETA ** (-(jnp.arange(half, dtype=jnp.float32) * 2.0 / ROT_DIM))
    ang = pos.astype(jnp.float32)[:, None] * inv[None, :]
    cos = jnp.cos(ang)[None, :, None, :]
    sin = jnp.sin(ang)[None, :, None, :]
    xf = x.astype(jnp.float32)
    x1 = xf[..., :half]
    x2 = xf[..., half:ROT_DIM]
    out = jnp.concatenate([x1 * cos - x2 * sin, x2 * cos + x1 * sin, xf[..., ROT_DIM:]], axis=-1)
    return out.astype(x.dtype)


def neighbourhood_attention(q, k, v, rpb):
    b, s, h, dh = q.shape
    rows = s // GRID_W
    kr = min(NA_ROWS, rows)
    kc = NA_COLS
    scale = dh ** -0.5
    q = q.reshape(b, rows, GRID_W, h, dh)
    k = k.reshape(b, rows, GRID_W, h, dh)
    v = v.reshape(b, rows, GRID_W, h, dh)
    cols = jnp.arange(GRID_W)
    col_start = jnp.clip(cols - kc // 2, 0, GRID_W - kc)
    col_idx = col_start[:, None] + jnp.arange(kc)[None, :]
    dc = col_idx - cols[:, None] + (NA_COLS - 1)

    def row_block(r):
        rs = jnp.clip(r - kr // 2, 0, rows - kr)
        kb = lax.dynamic_slice_in_dim(k, rs, kr, axis=1)[:, :, col_idx]
        vb = lax.dynamic_slice_in_dim(v, rs, kr, axis=1)[:, :, col_idx]
        qr = lax.dynamic_index_in_dim(q, r, axis=1, keepdims=False)
        sc = jnp.einsum('bchd,brckhd->bhcrk', qr, kb).astype(jnp.float32) * scale
        dr = rs + jnp.arange(kr) - r + (NA_ROWS - 1)
        bias = rpb[:, dr[None, :, None], dc[:, None, :]].astype(jnp.float32)
        sc = sc + bias[None]
        p = jax.nn.softmax(sc.reshape(b, h, GRID_W, kr * kc), axis=-1)
        p = p.reshape(b, h, GRID_W, kr, kc).astype(v.dtype)
        return jnp.einsum('bhcrk,brckhd->bchd', p, vb)

    o = lax.map(row_block, jnp.arange(rows))
    return o.transpose(1, 0, 2, 3, 4).reshape(b, s, h * dh)


def windowed_gqa(q, k, v, sinks):
    b, s, hq, dh = q.shape
    hkv = k.shape[2]
    grp = hq // hkv
    nb = s // WINDOW
    scale = dh ** -0.5
    pad = ((0, 0), (WINDOW, WINDOW), (0, 0), (0, 0))
    kp = jnp.pad(k, pad).reshape(b, nb + 2, WINDOW, hkv, dh)
    vp = jnp.pad(v, pad).reshape(b, nb + 2, WINDOW, hkv, dh)
    kw = jnp.concatenate([kp[:, :-2], kp[:, 1:-1], kp[:, 2:]], axis=2)
    vw = jnp.concatenate([vp[:, :-2], vp[:, 1:-1], vp[:, 2:]], axis=2)
    qb = q.reshape(b, nb, WINDOW, hkv, grp, dh)
    sc = jnp.einsum('bnqhgd,bnkhd->bnhgqk', qb, kw).astype(jnp.float32) * scale
    blk = jnp.arange(nb)[:, None] * WINDOW
    qpos = blk + jnp.arange(WINDOW)[None, :]
    kpos = blk - WINDOW + jnp.arange(3 * WINDOW)[None, :]
    valid = (jnp.abs(qpos[:, :, None] - kpos[:, None, :]) <= WINDOW) & (kpos[:, None, :] >= 0) & (kpos[:, None, :] < s)
    sc = jnp.where(valid[None, :, None, None], sc, NEG_INF)
    sink = sinks.astype(jnp.float32).reshape(hkv, grp)[None, None, :, :, None, None]
    m = jnp.maximum(jnp.max(sc, axis=-1, keepdims=True), sink)
    p = jnp.exp(sc - m)
    denom = jnp.sum(p, axis=-1, keepdims=True) + jnp.exp(sink - m)
    p = (p / denom).astype(v.dtype)
    o = jnp.einsum('bnhgqk,bnkhd->bnqhgd', p, vw)
    return o.reshape(b, s, hq * dh)


def cross_attention(h, mem_n, w_cq, w_ckv, w_co):
    b, s, _ = h.shape
    m = mem_n.shape[1]
    q = (h @ w_cq).reshape(b, s, CROSS_HEADS, CROSS_HEAD_DIM)
    kv = mem_n @ w_ckv
    k = kv[..., :CROSS_WIDTH].reshape(b, m, CROSS_HEADS, CROSS_HEAD_DIM)
    v = kv[..., CROSS_WIDTH:].reshape(b, m, CROSS_HEADS, CROSS_HEAD_DIM)
    sc = jnp.einsum('bshd,bmhd->bhsm', q, k).astype(jnp.float32) * (CROSS_HEAD_DIM ** -0.5)
    p = jax.nn.softmax(sc, axis=-1).astype(v.dtype)
    o = jnp.einsum('bhsm,bmhd->bshd', p, v).reshape(b, s, CROSS_WIDTH)
    return o @ w_co


def clamped_swiglu(g, u):
    g = jnp.minimum(g, SWIGLU_LIMIT)
    u = jnp.clip(u, -SWIGLU_LIMIT, SWIGLU_LIMIT)
    return (u + 1.0) * (g * jax.nn.sigmoid(SWIGLU_ALPHA * g))


def moe(h, w_router, b_router, w_gate, b_gate, w_up, b_up, w_down, b_down):
    b, s, d = h.shape
    t = b * s
    ht = h.reshape(t, d)
    logits = (ht @ w_router + b_router).astype(jnp.float32)
    top_val, top_idx = lax.top_k(logits, TOP_K)
    top_w = jax.nn.softmax(top_val, axis=-1).astype(h.dtype)
    n_assign = t * TOP_K
    flat_e = top_idx.reshape(n_assign)
    flat_tok = jnp.repeat(jnp.arange(t, dtype=jnp.int32), TOP_K)
    flat_w = top_w.reshape(n_assign)
    order = jnp.argsort(flat_e)
    sorted_e = flat_e[order]
    counts = jnp.bincount(flat_e, length=N_EXPERTS)
    padded = (counts + EXPERT_BLOCK - 1) // EXPERT_BLOCK * EXPERT_BLOCK
    pad_end = jnp.cumsum(padded)
    pad_start = pad_end - padded
    start = jnp.cumsum(counts) - counts
    dest = pad_start[sorted_e] + (jnp.arange(n_assign) - start[sorted_e])
    n_blocks = n_assign // EXPERT_BLOCK + N_EXPERTS
    n_rows = n_blocks * EXPERT_BLOCK
    row_tok = jnp.full((n_rows,), t, dtype=jnp.int32).at[dest].set(flat_tok[order])
    row_w = jnp.zeros((n_rows,), h.dtype).at[dest].set(flat_w[order])
    block_e = jnp.minimum(jnp.searchsorted(pad_end, jnp.arange(n_blocks) * EXPERT_BLOCK, side='right'), N_EXPERTS - 1)
    x_pad = jnp.concatenate([ht, jnp.zeros((1, d), h.dtype)], axis=0)
    xb = x_pad[row_tok].reshape(n_blocks, EXPERT_BLOCK, d)

    def expert_block(args):
        xe, e = args
        g = xe @ w_gate[e] + b_gate[e]
        u = xe @ w_up[e] + b_up[e]
        return clamped_swiglu(g, u) @ w_down[e] + b_down[e]

    yb = lax.map(expert_block, (xb, block_e)).reshape(n_rows, d)
    out = jnp.zeros((t + 1, d), h.dtype).at[row_tok].add(yb * row_w[:, None])[:t]
    return out.reshape(b, s, d)


def setup_inputs(seed: int = 0) -> dict:
    key = jax.random.key(seed)
    ks = jax.random.split(key, 26)
    f32 = jnp.float32

    def nrm(k, shape, scale):
        return jax.random.normal(k, shape, f32) * scale

    def gain(k, shape):
        return 1.0 + 0.1 * jax.random.normal(k, shape, f32)

    L = DEPTH
    return {
        "x": nrm(ks[0], (BATCH, SEQ, D_MODEL), 1.0),
        "mem": nrm(ks[1], (BATCH, MEM_LEN, D_MODEL), 1.0),
        "g_mix": gain(ks[2], (L, D_MODEL)),
        "w_in": nrm(ks[3], (L, D_MODEL, D_IN), D_MODEL ** -0.5),
        "rpb_na": nrm(ks[4], (L, NA_HEADS, 2 * NA_ROWS - 1, 2 * NA_COLS - 1), 0.5),
        "sinks": nrm(ks[5], (L, WIN_Q_HEADS), 1.0),
        "w_na_o": nrm(ks[6], (L, NA_WIDTH, D_MODEL), NA_WIDTH ** -0.5),
        "w_win_o": nrm(ks[7], (L, WIN_Q_WIDTH, D_MODEL), WIN_Q_WIDTH ** -0.5),
        "w_out": nrm(ks[8], (L, D_MODEL, D_MODEL), D_MODEL ** -0.5),
        "g_cross": gain(ks[9], (L, D_MODEL)),
        "g_mem": gain(ks[10], (L, D_MODEL)),
        "w_cq": nrm(ks[11], (L, D_MODEL, CROSS_WIDTH), D_MODEL ** -0.5),
        "w_ckv": nrm(ks[12], (L, D_MODEL, 2 * CROSS_WIDTH), D_MODEL ** -0.5),
        "w_co": nrm(ks[13], (L, CROSS_WIDTH, D_MODEL), CROSS_WIDTH ** -0.5),
        "g_moe": gain(ks[14], (L, D_MODEL)),
        "w_router": nrm(ks[15], (L, D_MODEL, N_EXPERTS), D_MODEL ** -0.5),
        "b_router": nrm(ks[16], (L, N_EXPERTS), 0.01),
        "w_gate": nrm(ks[17], (L, N_EXPERTS, D_MODEL, D_FF), D_MODEL ** -0.5),
        "b_gate": nrm(ks[18], (L, N_EXPERTS, D_FF), 0.01),
        "w_up": nrm(ks[19], (L, N_EXPERTS, D_MODEL, D_FF), D_MODEL ** -0.5),
        "b_up": nrm(ks[20], (L, N_EXPERTS, D_FF), 0.01),
        "w_down": nrm(ks[21], (L, N_EXPERTS, D_FF, D_MODEL), D_FF ** -0.5),
        "b_down": nrm(ks[22], (L, N_EXPERTS, D_MODEL), 0.01),
        "g_final": gain(ks[23], (D_MODEL,)),
    }


def reference(x, mem, g_mix, w_in, rpb_na, sinks, w_na_o, w_win_o, w_out, g_cross, g_mem, w_cq, w_ckv, w_co, g_moe, w_router, b_router, w_gate, b_gate, w_up, b_up, w_down, b_down, g_final):
    b, s, _ = x.shape
    pos = jnp.arange(s)
    splits = _split_points()
    for l in range(DEPTH):
        h = rmsnorm(x, g_mix[l])
        proj = h @ w_in[l]
        qa, ka, va, qb, kb, vb, ga, gb = jnp.split(proj, splits, axis=-1)
        ya = neighbourhood_attention(
            qa.reshape(b, s, NA_HEADS, HEAD_DIM),
            ka.reshape(b, s, NA_HEADS, HEAD_DIM),
            va.reshape(b, s, NA_HEADS, HEAD_DIM),
            rpb_na[l])
        qb = partial_rope(qb.reshape(b, s, WIN_Q_HEADS, HEAD_DIM), pos)
        kb = partial_rope(kb.reshape(b, s, WIN_KV_HEADS, HEAD_DIM), pos)
        yb = windowed_gqa(qb, kb, vb.reshape(b, s, WIN_KV_HEADS, HEAD_DIM), sinks[l])
        merged = jax.nn.sigmoid(ga) * (ya @ w_na_o[l]) + jax.nn.sigmoid(gb) * (yb @ w_win_o[l])
        x = x + merged @ w_out[l]
        x = x + cross_attention(rmsnorm(x, g_cross[l]), rmsnorm(mem, g_mem[l]), w_cq[l], w_ckv[l], w_co[l])
        x = x + moe(rmsnorm(x, g_moe[l]), w_router[l], b_router[l], w_gate[l], b_gate[l], w_up[l], b_up[l], w_down[l], b_down[l])
    return rmsnorm(x, g_final)
```

```cpp
#include <hip/hip_runtime.h>
#include <math.h>
#include <stdint.h>

#define LAS __attribute__((address_space(3)))
#define GAS __attribute__((address_space(1)))
typedef unsigned short bf16_t;
typedef short bf16x8 __attribute__((ext_vector_type(8)));
typedef short s16x4 __attribute__((ext_vector_type(4)));
typedef float f32x4 __attribute__((ext_vector_type(4)));
typedef float f32x2 __attribute__((ext_vector_type(2)));
typedef float f32x16 __attribute__((ext_vector_type(16)));
typedef unsigned u32x4 __attribute__((ext_vector_type(4)));
typedef unsigned u32x2 __attribute__((ext_vector_type(2)));

constexpr int D = 2048, BATCH = 4, SEQ = 4096, T = BATCH * SEQ, MEM = 256, NMEM = BATCH * MEM, DIN = 8704;
constexpr int NE = 32, TOPK = 4, NASSIGN = T * TOPK;
constexpr int PROJW = 4608;
constexpr int GATEW = 4096;
constexpr int MAXTILES = 288;
constexpr float EPS = 1e-5f;
constexpr int NWAVES = 8, NTHREADS = 512;
constexpr int LDS_BYTES = 155648;
constexpr int MISC_OFF = 155648 - 1024;

__device__ __forceinline__ float bf2f(bf16_t v) { return __uint_as_float((unsigned)v << 16); }
__device__ __forceinline__ unsigned f2bf(float f) { unsigned u = __float_as_uint(f); return (u + 0x7fffu + ((u >> 16) & 1u)) >> 16; }
__device__ __forceinline__ unsigned pk2(float lo, float hi) { return f2bf(lo) | (f2bf(hi) << 16); }
typedef __bf16 bf16x2_t __attribute__((ext_vector_type(2)));
__device__ __forceinline__ unsigned cvt_pk_bf16(float lo, float hi) { const f32x2 v = {lo, hi}; const bf16x2_t b = __builtin_convertvector(v, bf16x2_t); return __builtin_bit_cast(unsigned, b); }
__device__ __forceinline__ float wave_sum(float v) {
#pragma unroll
    for (int o = 1; o < 64; o <<= 1) v += __shfl_xor(v, o);
    return v;
}
typedef int v8i32 __attribute__((ext_vector_type(8)));
typedef int i32x4 __attribute__((ext_vector_type(4)));
__device__ __forceinline__ float clamp448(float x) { return fminf(fmaxf(x, -448.0f), 448.0f); }
__device__ __forceinline__ unsigned pk4_fp8(float a, float b, float c, float d) {
    int p = __builtin_amdgcn_cvt_pk_fp8_f32(clamp448(a), clamp448(b), 0, false);
    p = __builtin_amdgcn_cvt_pk_fp8_f32(clamp448(c), clamp448(d), p, true);
    return (unsigned)p;
}
#define LDS_WAIT() asm volatile("s_waitcnt lgkmcnt(0)" ::: "memory")
#define VM_WAIT() asm volatile("s_waitcnt vmcnt(0)" ::: "memory")

#define XB_TMO      128
#define XB_XCNT(j)  (256  + 64 * (j))
#define XB_XSUB(j)  (1280 + 64 * (j))
#define XB_XGEN(j)  (2304 + 64 * (j))
#define XB_TOP      3328
#define XB_TOPGEN   3392
#define XCD_BAR_WORDS 3456
#define XB_SPIN_CAP (1u << 18)

__device__ __forceinline__ unsigned xb_ld(unsigned* p)              { return __hip_atomic_load(p, __ATOMIC_RELAXED, __HIP_MEMORY_SCOPE_AGENT); }
__device__ __forceinline__ unsigned xb_add(unsigned* p, unsigned v) { return __hip_atomic_fetch_add(p, v, __ATOMIC_RELAXED, __HIP_MEMORY_SCOPE_AGENT); }
__device__ __forceinline__ unsigned xb_xcc_id() { return (unsigned)__builtin_amdgcn_s_getreg((3 << 11) | 20) & 0xFu; }
#define XB_SPIN(cond, bar) do { unsigned _sp = 0; while (cond) { __builtin_amdgcn_s_sleep(1); \
    if ((++_sp & 255u) == 0u) { if (xb_ld(&(bar)[XB_TMO])) break; if (_sp > XB_SPIN_CAP) { atomicAdd(&(bar)[XB_TMO], 1u); break; } } } } while (0)

struct XcdBarrier {
    unsigned* bar; unsigned x;
    volatile LAS unsigned* st;
};
__device__ __forceinline__ XcdBarrier xcd_barrier_post(unsigned* bar, volatile LAS unsigned* st) {
    XcdBarrier b; b.bar = bar; b.x = xb_xcc_id(); b.st = st;
    if (threadIdx.x == 0) (void)xb_add(&bar[XB_XCNT(b.x)], 1u);
    return b;
}
__device__ __forceinline__ void xcd_barrier_complete(unsigned* bar, unsigned x, unsigned& nloc, unsigned& nx) {
    const unsigned G = gridDim.x * gridDim.y * gridDim.z;
    unsigned sum, cnt, mine, sp = 0u;
    for (;;) {
        sum = 0u; cnt = 0u; mine = 0u;
#pragma unroll
        for (unsigned j = 0; j < 16; ++j) { const unsigned c = xb_ld(&bar[XB_XCNT(j)]); sum += c; cnt += (c > 0u) ? 1u : 0u; mine = (j == x) ? c : mine; }
        if (sum == G) break;
        __builtin_amdgcn_s_sleep(1);
        if ((++sp & 255u) == 0u) { if (xb_ld(&bar[XB_TMO])) break; if (sp > XB_SPIN_CAP) { atomicAdd(&bar[XB_TMO], 1u); break; } }
    }
    nloc = mine > 0u ? mine : 1u; nx = cnt > 0u ? cnt : 1u;
}
__device__ __forceinline__ void xcd_barrier(const XcdBarrier& b) {
    asm volatile("s_waitcnt vmcnt(0)" ::: "memory");
    __syncthreads();
    if (threadIdx.x == 0) {
        unsigned* bar = b.bar;
        __builtin_amdgcn_s_waitcnt(0);
        unsigned nloc = b.st[0], nx = b.st[1];
        if (nloc == 0u) { xcd_barrier_complete(bar, b.x, nloc, nx); b.st[0] = nloc; b.st[1] = nx; }
        const unsigned old = xb_add(&bar[XB_XSUB(b.x)], 1u);
        const unsigned gen = old / nloc;
        if (old + 1u == (gen + 1u) * nloc) {
            __builtin_amdgcn_fence(__ATOMIC_RELEASE, "agent");
            asm volatile("s_waitcnt vmcnt(0)" ::: "memory");
            const unsigned og = xb_add(&bar[XB_TOP], 1u);
            const unsigned tg = og / nx;
            if (og + 1u == (tg + 1u) * nx) xb_add(&bar[XB_TOPGEN], 1u);
            else XB_SPIN(xb_ld(&bar[XB_TOPGEN]) == tg, bar);
            __builtin_amdgcn_fence(__ATOMIC_ACQUIRE, "agent");
            xb_add(&bar[XB_XGEN(b.x)], 1u);
            asm volatile("s_waitcnt vmcnt(0)" ::: "memory");
        } else {
            XB_SPIN(xb_ld(&bar[XB_XGEN(b.x)]) == gen, bar);
            __builtin_amdgcn_fence(__ATOMIC_ACQUIRE, "agent");
            asm volatile("s_waitcnt vmcnt(0)" ::: "memory");
        }
    }
    __syncthreads();
}

#ifndef PG8_HALF_UNITS
#define PG8_HALF_UNITS 0
#endif
#ifndef PG8_KLOOP8
#define PG8_KLOOP8 0
#endif
constexpr int BM = 256, BK = 64, HALF = 128, HTB = HALF * BK * 2, STAGE_BYTES = 8 * HTB, NXCD = 8;
__device__ __forceinline__ int lds_byte(int r, int c) { const int st = (r >> 4) * 2 + (c >> 5), rr = r & 15, cc = c & 31, ob = rr * 64 + cc * 2; return st * 1024 + (ob ^ (((ob >> 9) & 1) << 5)); }
__device__ __forceinline__ void stage_rc(int b, int& R, int& C) { const int st = b / 1024, sb = b % 1024, swz = sb ^ (((sb >> 9) & 1) << 5); R = (st >> 1) * 16 + swz / 64; C = (st & 1) * 32 + (swz % 64) / 2; }
__device__ __forceinline__ int perm32(int rho) { const int n = rho >> 4, i = rho & 15; return 8 * (i >> 2) + 4 * n + (i & 3); }
struct Unit { int pm, pn, e, half; };

template <int WGM> __device__ __forceinline__ bool static_order(int nM, int nN, int G, int c, int i, int& pm, int& pn, int& half) {
    const int nwg = nM * nN, full = nwg / G, nrem = nwg - full * G;
    long L = (long)i * G + c; half = 0;
    if (i >= full) {
        if (i > full || nrem == 0) return false;
        if (PG8_HALF_UNITS && 2 * nrem <= G && (G & 15) == 0) { const int uu = (c >> 4) * 8 + (c & 7); if (uu >= nrem) return false; L = (long)full * G + uu; half = 1 + ((c >> 3) & 1); }
        else if (c >= nrem) return false;
    }
    int wgid = (int)L; { const int q = nwg / NXCD, r = nwg % NXCD, xcd = wgid % NXCD, off = wgid / NXCD; wgid = (xcd < r ? xcd * (q + 1) : r * (q + 1) + (xcd - r) * q) + off; }
    const int nig = WGM * nN, gid = wgid / nig, fm = gid * WGM, gsz = (nM - fm) < WGM ? (nM - fm) : WGM;
    pm = fm + ((wgid % nig) % gsz); pn = (wgid % nig) / gsz; return true;
}

__device__ __forceinline__ void mfma_f8_scaled(f32x4& acc, const v8i32& rows, const v8i32& cols, int unit_scales) {
    asm volatile("v_mfma_scale_f32_16x16x128_f8f6f4 %0, %1, %2, %0, %3, %3 op_sel_hi:[0,0,0]" : "+v"(acc) : "v"(rows), "v"(cols), "v"(unit_scales));
}
template <class Epi, class Sched, int VAR = 0, bool F8 = false>
__device__ __forceinline__ void gemm_phase(LAS unsigned char* lds, const int K, const Sched& S, const Epi& E) {
    const int tid = threadIdx.x, wid = __builtin_amdgcn_readfirstlane(tid >> 6), lane = tid & 63, wr = wid >> 2, wc = wid & 3, fr = lane & 15, fq = lane >> 4;
    const int nt = K / BK;
    int sR[2], sC[2]; unsigned voffB[2];
#pragma unroll
    for (int i = 0; i < 2; ++i) { int R, C; stage_rc(tid * 16 + i * 8192, R, C); sR[i] = R; sC[i] = C; const int Rb = (R & ~31) + perm32(R & 31); voffB[i] = (unsigned)(Rb * K + C) * 2u; }
    const size_t kstep = (size_t)(BK * 2);
    const size_t hstepB = (size_t)HALF * K * 2;
    const unsigned ldsw = (unsigned)wid * 1024u;
    const int aoff = lds_byte(wr * 64 + fr, fq * 8), boff = lds_byte(wc * 32 + fr, fq * 8);
#define PG8_SA(b, h) (((b) * 2 + (h)) * HTB)
#define PG8_SB(b, h) ((4 + (b) * 2 + (h)) * HTB)
#define PG8_STAGE(bufoff, gbase, voff) do { if constexpr (VAR != 3) _Pragma("unroll") for (int _i = 0; _i < 2; ++_i) \
        __builtin_amdgcn_global_load_lds((const unsigned*)((const char*)(gbase) + (voff)[_i]), (LAS unsigned*)(lds + (bufoff) + ldsw + _i * 8192), 16, 0, 0); } while (0)
#define PG8_LDA(dst, b, h) do { if constexpr (VAR != 2) _Pragma("unroll") for (int m = 0; m < 4; ++m) _Pragma("unroll") for (int k = 0; k < 2; ++k) dst[m][k] = *(const LAS bf16x8*)(lds + PG8_SA(b, h) + aoff + m * 2048 + k * 1024); } while (0)
#define PG8_LDB(dst, b, h) do { if constexpr (VAR != 2) _Pragma("unroll") for (int n = 0; n < 2; ++n) _Pragma("unroll") for (int k = 0; k < 2; ++k) dst[n][k] = *(const LAS bf16x8*)(lds + PG8_SB(b, h) + boff + n * 2048 + k * 1024); } while (0)
#define PG8_MMA(ai, bj, At, Bt) do { __builtin_amdgcn_s_setprio(1); if constexpr (VAR != 1) { if constexpr (F8) { \
        _Pragma("unroll") for (int m = 0; m < 4; ++m) _Pragma("unroll") for (int n = 0; n < 2; ++n) { \
            const i32x4 b0_ = __builtin_bit_cast(i32x4, Bt[n][0]), b1_ = __builtin_bit_cast(i32x4, Bt[n][1]), a0_ = __builtin_bit_cast(i32x4, At[m][0]), a1_ = __builtin_bit_cast(i32x4, At[m][1]); \
            const v8i32 bv_ = __builtin_shufflevector(b0_, b1_, 0, 1, 2, 3, 4, 5, 6, 7), av_ = __builtin_shufflevector(a0_, a1_, 0, 1, 2, 3, 4, 5, 6, 7); \
            mfma_f8_scaled(acc[ai][bj][m][n], bv_, av_, f8_scales); } \
        } else { _Pragma("unroll") for (int m = 0; m < 4; ++m) _Pragma("unroll") for (int n = 0; n < 2; ++n) _Pragma("unroll") for (int k = 0; k < 2; ++k) \
        acc[ai][bj][m][n] = __builtin_amdgcn_mfma_f32_16x16x32_bf16(Bt[n][k], At[m][k], acc[ai][bj][m][n], 0, 0, 0); } } __builtin_amdgcn_s_setprio(0); } while (0)
#define PG8_WAIT_V(n) asm volatile("s_waitcnt vmcnt(" #n ")" ::: "memory")
#define PG8_WAIT_L(n) asm volatile("s_waitcnt lgkmcnt(" #n ")" ::: "memory")
#define PG8_BAR __builtin_amdgcn_s_barrier()
#define PG8_SCHED __builtin_amdgcn_sched_barrier(0)
#define PG8_KBODY(MMA_A0, MMA_A1, HALFB) \
            const bool last = (t == nt - 2); \
            if constexpr (Epi::HAS_MID) { if (t == nt / 2) E.template mid<HALFB>(acc, cur, wr, wc, fr, fq); } \
            const char* a1 = cA + (size_t)(t + 1) * kstep; \
            const char* a2 = last ? nA : cA + (size_t)(t + 2) * kstep; const char* b2 = last ? nB : cB + (size_t)(t + 2) * kstep; \
            const char* a3 = a2 + kstep; const char* b3 = b2 + kstep; \
            unsigned v20[2], v21[2]; \
_Pragma("unroll") \
            for (int i = 0; i < 2; ++i) { v20[i] = (Sched::GATHER && last) ? nV0[i] : cV0[i]; v21[i] = (Sched::GATHER && last) ? nV1[i] : cV1[i]; } \
            PG8_LDB(B0, 0, 0); PG8_LDB(B1, 0, 1); PG8_SCHED; PG8_LDA(At, 0, 0); PG8_STAGE(PG8_SA(1, 1), a1, cV1); \
            PG8_WAIT_V(8); PG8_WAIT_L(0); PG8_BAR; MMA_A0 PG8_BAR; PG8_SCHED; \
            PG8_LDA(At, 0, 1); PG8_STAGE(PG8_SB(0, 0), b2, voffB); PG8_STAGE(PG8_SB(0, 1), b2 + hstepB, voffB); PG8_STAGE(PG8_SA(0, 0), a2, v20); \
            PG8_WAIT_V(8); PG8_WAIT_L(0); PG8_BAR; MMA_A1 PG8_BAR; PG8_SCHED; \
            PG8_LDB(B0, 1, 0); PG8_LDB(B1, 1, 1); PG8_SCHED; PG8_LDA(At, 1, 0); PG8_STAGE(PG8_SA(0, 1), a2, v21); \
            PG8_WAIT_V(8); PG8_WAIT_L(0); PG8_BAR; MMA_A0 PG8_BAR; PG8_SCHED; \
            PG8_LDA(At, 1, 1); PG8_STAGE(PG8_SB(1, 0), b3, voffB); PG8_STAGE(PG8_SB(1, 1), b3 + hstepB, voffB); PG8_STAGE(PG8_SA(1, 0), a3, v20); \
            PG8_WAIT_V(8); PG8_WAIT_L(0); PG8_BAR; MMA_A1 PG8_BAR; PG8_SCHED;
#define PG8_KBODY8(HALFB) \
            const bool last = (t == nt - 2); \
            if constexpr (Epi::HAS_MID) { if (t == nt / 2) E.template mid<HALFB>(acc, cur, wr, wc, fr, fq); } \
            const char* a1 = cA + (size_t)(t + 1) * kstep; \
            const char* a2 = last ? nA : cA + (size_t)(t + 2) * kstep; const char* b2 = last ? nB : cB + (size_t)(t + 2) * kstep; \
            const char* a3 = a2 + kstep; const char* b3 = b2 + kstep; \
            unsigned v20[2], v21[2]; \
_Pragma("unroll") \
            for (int i = 0; i < 2; ++i) { v20[i] = (Sched::GATHER && last) ? nV0[i] : cV0[i]; v21[i] = (Sched::GATHER && last) ? nV1[i] : cV1[i]; } \
            PG8_LDB(B0, 0, 0); PG8_SCHED; PG8_LDA(At, 0, 0); PG8_STAGE(PG8_SA(1, 1), a1, cV1); \
            PG8_WAIT_L(8); PG8_BAR; PG8_WAIT_L(0); PG8_MMA(0, 0, At, B0); PG8_BAR; PG8_SCHED; \
            PG8_LDB(B1, 0, 1); PG8_STAGE(PG8_SB(0, 0), b2, voffB); \
            PG8_BAR; PG8_WAIT_L(0); PG8_MMA(0, 1, At, B1); PG8_BAR; \
            PG8_LDA(At, 0, 1); PG8_STAGE(PG8_SA(0, 0), a2, v20); \
            PG8_BAR; PG8_WAIT_L(0); PG8_MMA(1, 0, At, B0); PG8_BAR; PG8_SCHED; \
            PG8_STAGE(PG8_SB(0, 1), b2 + hstepB, voffB); \
            PG8_WAIT_V(6); PG8_BAR; PG8_MMA(1, 1, At, B1); PG8_BAR; \
            PG8_LDB(B0, 1, 0); PG8_SCHED; PG8_LDA(At, 1, 0); PG8_STAGE(PG8_SA(0, 1), a2, v21); \
            PG8_WAIT_L(8); PG8_BAR; PG8_WAIT_L(0); PG8_MMA(0, 0, At, B0); PG8_BAR; PG8_SCHED; \
            PG8_LDB(B1, 1, 1); PG8_STAGE(PG8_SB(1, 0), b3, voffB); \
            PG8_BAR; PG8_WAIT_L(0); PG8_MMA(0, 1, At, B1); PG8_BAR; \
            PG8_LDA(At, 1, 1); PG8_STAGE(PG8_SA(1, 0), a3, v20); \
            PG8_BAR; PG8_WAIT_L(0); PG8_MMA(1, 0, At, B0); PG8_BAR; PG8_SCHED; \
            PG8_STAGE(PG8_SB(1, 1), b3 + hstepB, voffB); \
            PG8_WAIT_V(6); PG8_BAR; PG8_MMA(1, 1, At, B1); PG8_BAR;
    const int f8_scales = 0x7F7F7F7F;
    Unit cur, nxt; int ui = 0;
    if (!S.next(0, cur)) return;
    f32x4 acc[2][2][4][2];
#pragma unroll
    for (int a = 0; a < 2; ++a)
#pragma unroll
        for (int b = 0; b < 2; ++b)
#pragma unroll
            for (int m = 0; m < 4; ++m)
#pragma unroll
                for (int n = 0; n < 2; ++n) acc[a][b][m][n] = (f32x4){0.f, 0.f, 0.f, 0.f};
    bf16x8 At[4][2] = {}, B0[2][2] = {}, B1[2][2] = {};
    unsigned cV0[2], cV1[2], nV0[2], nV1[2];
    S.a_voff(cur, cV0, cV1, sR, sC);
#pragma unroll
    for (int i = 0; i < 2; ++i) { nV0[i] = cV0[i]; nV1[i] = cV1[i]; }
    const char* cA = S.a_base(cur); const char* cB = S.b_base(cur);
#if PG8_KLOOP8
    PG8_STAGE(PG8_SB(0, 0), cB, voffB); PG8_STAGE(PG8_SA(0, 0), cA, cV0); PG8_STAGE(PG8_SB(0, 1), cB + hstepB, voffB); PG8_STAGE(PG8_SA(0, 1), cA, cV1);
    if (wr == 1) PG8_BAR;
    PG8_WAIT_V(4); PG8_BAR;
#else
    PG8_STAGE(PG8_SB(0, 0), cB, voffB); PG8_STAGE(PG8_SB(0, 1), cB + hstepB, voffB); PG8_STAGE(PG8_SA(0, 0), cA, cV0); PG8_STAGE(PG8_SA(0, 1), cA, cV1);
    if (wr == 1) PG8_BAR;
    PG8_WAIT_V(2); PG8_BAR;
#endif
    PG8_STAGE(PG8_SB(1, 0), cB + kstep, voffB); PG8_STAGE(PG8_SA(1, 0), cA + kstep, cV0); PG8_STAGE(PG8_SB(1, 1), cB + hstepB + kstep, voffB);
    PG8_WAIT_V(6); PG8_BAR;
    for (;;) {
        const bool has_next = S.next(ui + 1, nxt);
        const char* nA = has_next ? S.a_base(nxt) : cA; const char* nB = has_next ? S.b_base(nxt) : cB;
        if constexpr (Sched::GATHER) { if (has_next) S.a_voff(nxt, nV0, nV1, sR, sC); }
#if PG8_KLOOP8
        if (true) {
            for (int t = 0; t < nt; t += 2) { PG8_KBODY8(false) }
        } else
#endif
        if (cur.half == 0) {
            for (int t = 0; t < nt; t += 2) { PG8_KBODY({ PG8_MMA(0, 0, At, B0); PG8_MMA(0, 1, At, B1); }, { PG8_MMA(1, 0, At, B0); PG8_MMA(1, 1, At, B1); }, false) }
        } else {
            const int hf = cur.half;
            for (int t = 0; t < nt; t += 2) { PG8_KBODY(if (hf != 2) { PG8_MMA(0, 0, At, B0); PG8_MMA(0, 1, At, B1); }, if (hf != 1) { PG8_MMA(1, 0, At, B0); PG8_MMA(1, 1, At, B1); }, true) }
        }
        if constexpr (F8) asm volatile("s_nop 15\n\ts_nop 7" ::: "memory");
        if (wr == 0) PG8_BAR;
        if (cur.half == 0) E.template run<false>(acc, cur, wr, wc, fr, fq); else E.template run<true>(acc, cur, wr, wc, fr, fq);
        if (!has_next) break;
#pragma unroll
        for (int a = 0; a < 2; ++a)
#pragma unroll
            for (int b = 0; b < 2; ++b)
#pragma unroll
                for (int m = 0; m < 4; ++m)
#pragma unroll
                    for (int n = 0; n < 2; ++n) acc[a][b][m][n] = (f32x4){0.f, 0.f, 0.f, 0.f};
        cur = nxt; cA = nA; cB = nB; ++ui;
        if constexpr (Sched::GATHER) {
#pragma unroll
            for (int i = 0; i < 2; ++i) { cV0[i] = nV0[i]; cV1[i] = nV1[i]; }
        }
        if (wr == 1) PG8_BAR;
    }
    PG8_WAIT_V(0);
    PG8_BAR;
#undef PG8_SA
#undef PG8_SB
#undef PG8_STAGE
#undef PG8_LDA
#undef PG8_LDB
#undef PG8_MMA
#undef PG8_WAIT_V
#undef PG8_WAIT_L
#undef PG8_BAR
#undef PG8_SCHED
#undef PG8_KBODY
#undef PG8_KBODY8
}

template <int WGM = 4> struct SchedPlainT {
    static constexpr bool GATHER = false;
    const char* A; const char* Bt; int K, nM, nN, G, c;
    __device__ __forceinline__ bool next(int i, Unit& u) const { u.e = 0; return static_order<WGM>(nM, nN, G, c, i, u.pm, u.pn, u.half); }
    __device__ __forceinline__ const char* a_base(const Unit& u) const { return A + (size_t)u.pm * BM * K * 2; }
    __device__ __forceinline__ const char* b_base(const Unit& u) const { return Bt + (size_t)u.pn * BM * K * 2; }
    __device__ __forceinline__ void a_voff(const Unit&, unsigned (&v0)[2], unsigned (&v1)[2], const int (&sR)[2], const int (&sC)[2]) const {
#pragma unroll
        for (int i = 0; i < 2; ++i) { v0[i] = (unsigned)(sR[i] * K + sC[i]) * 2u; v1[i] = (unsigned)((sR[i] + HALF) * K + sC[i]) * 2u; }
    }
};
typedef SchedPlainT<4> SchedPlain;
constexpr size_t WS_CTL   = 0;
constexpr int    CW_CNT   = 4096;
constexpr int    CW_DQ    = 4352;
constexpr size_t WS_SS1   = 65536;
constexpr size_t WS_SS2   = WS_SS1 + (size_t)T * 4;
constexpr size_t WS_ZERO_BYTES = WS_SS2 + (size_t)T * 4;
constexpr size_t WS_TE    = WS_ZERO_BYTES;
constexpr size_t WS_TP    = WS_TE + (size_t)NASSIGN * 4;
constexpr size_t WS_TW    = WS_TP + (size_t)NASSIGN * 4;
constexpr size_t WS_ROPE  = WS_TW + (size_t)NASSIGN * 4;
constexpr size_t WS_WRG   = WS_ROPE + (size_t)SEQ * 8 * 8;
constexpr size_t WS_LIST  = WS_WRG + (size_t)D * NE * 4;
constexpr size_t WS_WIN_T = WS_LIST + (size_t)NE * T * 4;
constexpr size_t WS_WOA_T = WS_WIN_T + (size_t)DIN * D * 2;
constexpr size_t WS_WOUT_T = WS_WOA_T + (size_t)D * D * 2;
constexpr size_t WS_WCQ_T = WS_WOUT_T + (size_t)D * D * 2;
constexpr size_t WS_WCKV_T = WS_WCQ_T + (size_t)512 * D * 2;
constexpr size_t WS_WCO_T = WS_WCKV_T + (size_t)1024 * D * 2;
constexpr size_t WS_WGU_T = WS_WCO_T + (size_t)D * 512 * 2;
constexpr size_t WS_WD_T  = WS_WGU_T + (size_t)NE * 4096 * D * 2;
constexpr size_t WS_XB    = WS_WD_T + (size_t)NE * D * D * 2;
constexpr size_t WS_MEMB  = WS_XB + (size_t)T * D * 2;
constexpr size_t WS_PROJB = WS_MEMB + (size_t)NMEM * D * 2;
constexpr size_t WS_GATES = WS_PROJB + (size_t)T * PROJW * 2;
constexpr size_t WS_Y     = WS_GATES + (size_t)T * GATEW * 2;
constexpr size_t WS_YMOE  = WS_PROJB;
constexpr size_t WS_MERGED = WS_Y + (size_t)T * D * 2;
constexpr size_t WS_X1    = WS_MERGED + (size_t)T * D * 2;
constexpr size_t WS_QC    = WS_X1 + (size_t)T * D * 4;
constexpr size_t WS_KVC   = WS_QC + (size_t)T * 512 * 2;
constexpr size_t WS_OC    = WS_KVC + (size_t)NMEM * 1024 * 2;
constexpr size_t WS_ACT   = WS_OC + (size_t)T * 512 * 2;
constexpr size_t WS_END   = WS_ACT + (size_t)MAXTILES * 256 * D * 2;
static_assert(WS_Y + (size_t)T * D * 2 - WS_PROJB >= (size_t)MAXTILES * 256 * D * 2, "YMOE overlay fits");
static_assert(WS_END <= (size_t)2147483648u, "workspace fits in 2 GiB");
static_assert(WS_TE % 256 == 0 && WS_WIN_T % 256 == 0 && WS_XB % 256 == 0 && WS_X1 % 256 == 0 && WS_ACT % 256 == 0, "alignment");

struct Args {
    const float* in[24]; float* out; unsigned char* ws; int ph_lo, ph_hi;
};

#ifndef F8_GU
#define F8_GU 1
#endif
#ifndef F8_P1
#define F8_P1 1
#endif
#ifndef F8_Y
#define F8_Y 1
#endif
#ifndef F8_DN
#define F8_DN 1
#endif
struct P0Item { const float* W; const float* g; bf16_t* WT; int N, ldk, kofs, drow0, k0, n0, q8; };
__device__ __forceinline__ void p0_load(const P0Item& t, f32x4 (&v)[16], int lane) {
    const int lr = lane >> 4, lc = 4 * (lane & 15);
#pragma unroll
    for (int i = 0; i < 16; ++i) {
        const char* base = (const char*)(t.W + (size_t)(t.k0 + 4 * i) * t.N + t.n0);
        v[i] = __builtin_nontemporal_load((const f32x4*)(base + (size_t)(unsigned)((lr * t.N + lc) * 4)));
    }
}
__device__ __forceinline__ void p0_finish(const P0Item& t, f32x4 (&v)[16], LAS float* scr, int lane) {
    const int lr = lane >> 4, lc = 4 * (lane & 15);
    if (t.g) {
#pragma unroll
        for (int i = 0; i < 16; ++i) { const float gs = t.g[t.k0 + lr + 4 * i]; v[i] = v[i] * gs; }
    }
#pragma unroll
    for (int i = 0; i < 16; ++i) { LAS float* s = scr + (lr + 4 * i) * 65 + lc; s[0] = v[i][0]; s[1] = v[i][1]; s[2] = v[i][2]; s[3] = v[i][3]; }
    LDS_WAIT(); asm volatile("" ::: "memory");
    if (t.q8) {
        const int c4 = lane & 3;
#pragma unroll
        for (int j = 0; j < 4; ++j) { const int n = (lane >> 2) + 16 * j; const LAS float* s = scr + (16 * c4) * 65 + n;
            u32x4 o;
            o.x = pk4_fp8(s[0 * 65] * 64.f, s[1 * 65] * 64.f, s[2 * 65] * 64.f, s[3 * 65] * 64.f);     o.y = pk4_fp8(s[4 * 65] * 64.f, s[5 * 65] * 64.f, s[6 * 65] * 64.f, s[7 * 65] * 64.f);
            o.z = pk4_fp8(s[8 * 65] * 64.f, s[9 * 65] * 64.f, s[10 * 65] * 64.f, s[11 * 65] * 64.f);   o.w = pk4_fp8(s[12 * 65] * 64.f, s[13 * 65] * 64.f, s[14 * 65] * 64.f, s[15 * 65] * 64.f);
            __builtin_nontemporal_store(o, (u32x4*)((unsigned char*)t.WT + (size_t)(t.drow0 + n) * t.ldk + t.kofs + t.k0 + 16 * c4)); }
        LDS_WAIT(); asm volatile("" ::: "memory");
        return;
    }
    const int c = lane & 7;
#pragma unroll
    for (int j = 0; j < 8; ++j) { const int n = (lane >> 3) + 8 * j; const LAS float* s = scr + (8 * c) * 65 + n;
        u32x4 o; o.x = cvt_pk_bf16(s[0 * 65], s[1 * 65]); o.y = cvt_pk_bf16(s[2 * 65], s[3 * 65]); o.z = cvt_pk_bf16(s[4 * 65], s[5 * 65]); o.w = cvt_pk_bf16(s[6 * 65], s[7 * 65]);
        __builtin_nontemporal_store(o, (u32x4*)(t.WT + (size_t)(t.drow0 + n) * t.ldk + t.kofs + t.k0 + 8 * c)); }
    LDS_WAIT(); asm volatile("" ::: "memory");
}
__device__ __forceinline__ void rms_row_to_bf16(const float* __restrict__ xrow, bf16_t* __restrict__ orow, int lane) {
    const f32x4* xr = (const f32x4*)xrow + lane;
    f32x4 v[8]; float s = 0.f;
#pragma unroll
    for (int j = 0; j < 8; ++j) { v[j] = xr[64 * j]; s += (v[j][0] * v[j][0] + v[j][1] * v[j][1]) + (v[j][2] * v[j][2] + v[j][3] * v[j][3]); }
    const float rstd = 1.0f / sqrtf(wave_sum(s) * (1.0f / D) + EPS);
    u32x2* o8 = (u32x2*)orow + lane;
#pragma unroll
    for (int j = 0; j < 8; ++j) { u32x2 o; o.x = pk2(v[j][0] * rstd, v[j][1] * rstd); o.y = pk2(v[j][2] * rstd, v[j][3] * rstd); o8[64 * j] = o; }
}
constexpr int SCRW = 128 * 33 * 4;
__device__ __forceinline__ void p0_load_w(const P0Item& t, f32x4 (&v)[16], int lane) {
    const int lr = lane >> 3, lc = 4 * (lane & 7);
#pragma unroll
    for (int i = 0; i < 16; ++i) {
        const char* base = (const char*)(t.W + (size_t)(t.k0 + 8 * i) * t.N + t.n0);
        v[i] = __builtin_nontemporal_load((const f32x4*)(base + (size_t)(unsigned)((lr * t.N + lc) * 4)));
    }
}
template<int GAIN> __device__ __forceinline__ void p0_finish_w(const P0Item& t, f32x4 (&v)[16], LAS float* scr, const LAS float* gl, int lane) {
    const int lr = lane >> 3, lc = 4 * (lane & 7);
#pragma unroll
    for (int i = 0; i < 16; ++i) { LAS float* s = scr + (lr + 8 * i) * 33 + lc; s[0] = v[i][0]; s[1] = v[i][1]; s[2] = v[i][2]; s[3] = v[i][3]; }
    LDS_WAIT(); asm volatile("" ::: "memory");
    const int c8 = lane & 7;
    f32x4 g0 = {64.f, 64.f, 64.f, 64.f}, g1 = g0, g2 = g0, g3 = g0;
    if (GAIN == 1) { const LAS f32x4* gp = (const LAS f32x4*)(gl + t.k0 + 16 * c8); g0 = gp[0]; g1 = gp[1]; g2 = gp[2]; g3 = gp[3]; }
    if (GAIN == 2) { const f32x4* gp = (const f32x4*)(t.g + t.k0 + 16 * c8); g0 = gp[0] * 64.f; g1 = gp[1] * 64.f; g2 = gp[2] * 64.f; g3 = gp[3] * 64.f; }
#pragma unroll
    for (int j = 0; j < 4; ++j) { const int n = (lane >> 3) + 8 * j; const LAS float* s = scr + (16 * c8) * 33 + n;
        u32x4 o;
        o.x = pk4_fp8(s[0 * 33] * g0[0], s[1 * 33] * g0[1], s[2 * 33] * g0[2], s[3 * 33] * g0[3]);     o.y = pk4_fp8(s[4 * 33] * g1[0], s[5 * 33] * g1[1], s[6 * 33] * g1[2], s[7 * 33] * g1[3]);
        o.z = pk4_fp8(s[8 * 33] * g2[0], s[9 * 33] * g2[1], s[10 * 33] * g2[2], s[11 * 33] * g2[3]);   o.w = pk4_fp8(s[12 * 33] * g3[0], s[13 * 33] * g3[1], s[14 * 33] * g3[2], s[15 * 33] * g3[3]);
        unsigned char* base = (unsigned char*)t.WT + (size_t)(t.drow0 + 8 * j) * t.ldk + t.kofs + t.k0;
        __builtin_nontemporal_store(o, (u32x4*)(base + (size_t)(unsigned)((lane >> 3) * t.ldk + 16 * c8))); }
    LDS_WAIT(); asm volatile("" ::: "memory");
}
#ifndef MAP_CONTIG
#define MAP_CONTIG 0
#endif
#ifndef GU_DB
#define GU_DB 1
#endif
#ifndef DEFER_N3
#define DEFER_N3 10
#endif
#ifndef DEFER_N4
#define DEFER_N4 10
#endif
#ifndef DEFER_N7
#define DEFER_N7 10
#endif
constexpr int P0_I_IN = 32 * 136, P0_I_NA = 16 * 32, P0_I_WIN = 16 * 32, P0_I_OUT = 32 * 32, P0_I_CQ = 32 * 8, P0_I_CKV = 32 * 16, P0_I_CO = 8 * 32, P0_I_E = 32 * 32;
constexpr int P0_I_SMALL = P0_I_IN + P0_I_NA + P0_I_WIN + P0_I_OUT + P0_I_CQ + P0_I_CKV + P0_I_CO;
constexpr int GU_TILES = 2 * NE * P0_I_E, GU_P0_TILES = GU_TILES - 2048 * (DEFER_N3 + DEFER_N4 + DEFER_N7);
static_assert(GU_P0_TILES >= 0 && GU_P0_TILES % 1024 == 0, "deferred tiles: the prologue (64k x 64n tiles) and the hosts (128k x 32n tiles) split the gate/up matrices at matrix granularity");
__device__ __forceinline__ void p0_decode(const Args& a, int it, P0Item& t) {
    unsigned char* ws = a.ws;
    const float* W; const float* g = nullptr; bf16_t* WT; int N, ldk, kofs = 0, nblk, r = it; bool gu = false, up = false;
    bool q8in = false;
    if (r < P0_I_IN) { W = a.in[3]; N = DIN; g = a.in[2]; WT = (bf16_t*)(ws + WS_WIN_T); ldk = D; nblk = 136; q8in = F8_P1 != 0; }
    else if ((r -= P0_I_IN) < P0_I_NA) { W = a.in[6]; N = D; WT = (bf16_t*)(ws + WS_WOA_T); ldk = D; nblk = 32; }
    else if ((r -= P0_I_NA) < P0_I_WIN) { W = a.in[7]; N = D; WT = (bf16_t*)(ws + WS_WOA_T); ldk = D; kofs = 1024; nblk = 32; }
    else if ((r -= P0_I_WIN) < P0_I_OUT) { W = a.in[8]; N = D; WT = (bf16_t*)(ws + WS_WOUT_T); ldk = D; nblk = 32; }
    else if ((r -= P0_I_OUT) < P0_I_CQ) { W = a.in[11]; N = 512; g = a.in[9]; WT = (bf16_t*)(ws + WS_WCQ_T); ldk = D; nblk = 8; }
    else if ((r -= P0_I_CQ) < P0_I_CKV) { W = a.in[12]; N = 1024; g = a.in[10]; WT = (bf16_t*)(ws + WS_WCKV_T); ldk = D; nblk = 16; }
    else if ((r -= P0_I_CKV) < P0_I_CO) { W = a.in[13]; N = D; WT = (bf16_t*)(ws + WS_WCO_T); ldk = 512; nblk = 32; }
    else { r -= P0_I_CO; const int mtx = r / P0_I_E; r -= mtx * P0_I_E; const int e = mtx >> 1, which = mtx & 1; N = D; nblk = 32; ldk = D;
        W = a.in[which == 0 ? 17 : 19] + (size_t)e * D * D; g = a.in[14]; gu = true; up = (which == 1);
        WT = F8_GU ? (bf16_t*)(ws + WS_WGU_T + (size_t)e * 4096 * D) : (bf16_t*)(ws + WS_WGU_T) + (size_t)e * 4096 * D; }
    const int q8 = ((gu && F8_GU) || q8in) ? 1 : 0;
    if (q8) nblk *= 2;
    const int kb = r / nblk, nb = r - kb * nblk, k0 = (q8 ? 128 : 64) * kb, n0 = (q8 ? 32 : 64) * nb;
    t.W = W; t.g = g; t.WT = WT; t.N = N; t.ldk = ldk; t.kofs = kofs; t.k0 = k0; t.n0 = n0; t.q8 = q8;
    t.drow0 = gu ? 256 * (n0 >> 7) + (n0 & 127) + (up ? 128 : 0) : n0;
}
__device__ __forceinline__ void rms_row_to_fp8(const float* __restrict__ xrow, unsigned char* __restrict__ orow, int lane) {
    const f32x4* xr = (const f32x4*)xrow + lane;
    f32x4 v[8]; float s = 0.f;
#pragma unroll
    for (int j = 0; j < 8; ++j) { v[j] = xr[64 * j]; s += (v[j][0] * v[j][0] + v[j][1] * v[j][1]) + (v[j][2] * v[j][2] + v[j][3] * v[j][3]); }
    const float rstd = 1.0f / sqrtf(wave_sum(s) * (1.0f / D) + EPS);
    unsigned* o4 = (unsigned*)orow + lane;
#pragma unroll
    for (int j = 0; j < 8; ++j) o4[64 * j] = pk4_fp8(v[j][0] * rstd, v[j][1] * rstd, v[j][2] * rstd, v[j][3] * rstd);
}
__device__ __forceinline__ void p0_prologue(const Args& a, LAS unsigned char* lds, int vcu, int G) {
    const int lane = threadIdx.x & 63, wave = __builtin_amdgcn_readfirstlane(threadIdx.x >> 6);
    LAS float* scr = (LAS float*)(lds + wave * SCRW);
    const int gw = vcu * NWAVES + wave, NGW = G * NWAVES;
    unsigned char* ws = a.ws;
    constexpr int NITEMS = P0_I_SMALL + GU_P0_TILES;
    auto decode = [&](int it, P0Item& t) { p0_decode(a, it, t); };
    {
        f32x4 va[16], vb[16]; P0Item ta, tb; int it = gw;
        auto load = [&](const P0Item& t, f32x4 (&v)[16]) { if (t.q8) p0_load_w(t, v, lane); else p0_load(t, v, lane); };
        auto finish = [&](const P0Item& t, f32x4 (&v)[16]) { if (t.q8) { if (t.g) p0_finish_w<2>(t, v, scr, nullptr, lane); else p0_finish_w<0>(t, v, scr, nullptr, lane); } else p0_finish(t, v, scr, lane); };
        if (it < NITEMS) { decode(it, ta); load(ta, va); }
        while (it < NITEMS) {
            const int it1 = it + NGW, it2 = it + 2 * NGW;
            if (it1 < NITEMS) { decode(it1, tb); load(tb, vb); }
            finish(ta, va);
            if (it1 >= NITEMS) break;
            if (it2 < NITEMS) { decode(it2, ta); load(ta, va); }
            finish(tb, vb);
            it = it2;
        }
    }
    if (F8_P1) { for (int m = gw; m < T; m += NGW) rms_row_to_fp8(a.in[0] + (size_t)m * D, (unsigned char*)(ws + WS_XB) + (size_t)m * D, lane); }
    else { for (int m = gw; m < T; m += NGW) rms_row_to_bf16(a.in[0] + (size_t)m * D, (bf16_t*)(ws + WS_XB) + (size_t)m * D, lane); }
    for (int m = gw; m < NMEM; m += NGW) rms_row_to_bf16(a.in[1] + (size_t)m * D, (bf16_t*)(ws + WS_MEMB) + (size_t)m * D, lane);
    const int gt = vcu * NTHREADS + threadIdx.x, NGT = G * NTHREADS;
    for (int i = gt; i < D * NE; i += NGT) ((float*)(ws + WS_WRG))[i] = a.in[14][i >> 5] * a.in[15][i];
    for (int i = gt; i < SEQ * 8; i += NGT) {
        const int pos = i >> 3, k = i & 7; const float inv = exp2f(-(float)k * 0.125f * 18.931568569324174f); const float ang = (float)pos * inv;
        const double rev = (double)ang * 0.15915494309189535; const float fr = (float)(rev - floor(rev));
        ((float2*)(ws + WS_ROPE))[i] = make_float2(__builtin_amdgcn_cosf(fr), __builtin_amdgcn_sinf(fr));
    }
}

template<int CNT, int GAIN, class Dec> __device__ __forceinline__ void convert_run(LAS float* scr, const LAS float* gl, int lane, Dec dec) {
    if (CNT <= 0) return;
    f32x4 va[16], vb[16]; P0Item ta, tb;
    dec(0, ta); p0_load_w(ta, va, lane);
    int n = 0;
#pragma unroll 1
    for (; n + 2 < CNT; n += 2) {
        dec(n + 1, tb); p0_load_w(tb, vb, lane);
        p0_finish_w<GAIN>(ta, va, scr, gl, lane);
        dec(n + 2, ta); p0_load_w(ta, va, lane);
        p0_finish_w<GAIN>(tb, vb, scr, gl, lane);
    }
    if (CNT % 2 == 0) { dec(CNT - 1, tb); p0_load_w(tb, vb, lane); p0_finish_w<GAIN>(ta, va, scr, gl, lane); p0_finish_w<GAIN>(tb, vb, scr, gl, lane); }
    else p0_finish_w<GAIN>(ta, va, scr, gl, lane);
}
static_assert(F8_DN && F8_GU, "the hosted conversion writes fp8 tiles");
__device__ __forceinline__ void down_item(const Args& a, int it, P0Item& t) {
    const int e = it >> 10, r = it & 1023, kb = r >> 6, nb = r & 63;
    t.W = a.in[21] + (size_t)e * D * D; t.g = nullptr; t.WT = (bf16_t*)(a.ws + WS_WD_T + (size_t)e * D * D); t.N = D; t.ldk = D; t.kofs = 0; t.k0 = 128 * kb; t.n0 = 32 * nb; t.drow0 = 32 * nb; t.q8 = 1;
}
template<int CNT> __device__ __forceinline__ void convert_down_static(const Args& a, LAS unsigned char* lds, int first, int widx_, int stride) {
    const int lane = threadIdx.x & 63, wave = __builtin_amdgcn_readfirstlane(threadIdx.x >> 6);
    const int widx = __builtin_amdgcn_readfirstlane(widx_);
    LAS float* scr = (LAS float*)(lds + wave * SCRW);
    convert_run<CNT, 0>(scr, nullptr, lane, [&](int n, P0Item& t) { down_item(a, MAP_CONTIG ? first + widx * CNT + n : first + widx + stride * n, t); });
}
__device__ __forceinline__ void convert_down_drain(const Args& a, LAS unsigned char* lds, int first) {
    const int lane = threadIdx.x & 63, wave = __builtin_amdgcn_readfirstlane(threadIdx.x >> 6);
    LAS float* scr = (LAS float*)(lds + wave * SCRW);
    unsigned* dq = (unsigned*)(a.ws + WS_CTL) + CW_DQ;
    constexpr int NT = NE * 32 * 32;
    for (;;) {
        unsigned c = 0; if (lane == 0) c = __hip_atomic_fetch_add(dq, 1u, __ATOMIC_RELAXED, __HIP_MEMORY_SCOPE_AGENT);
        const int base = first + 4 * (int)__builtin_amdgcn_readfirstlane(c);
        if (base >= NT) break;
        convert_run<4, 0>(scr, nullptr, lane, [&](int n, P0Item& t) { down_item(a, base + n, t); });
    }
}
__device__ __forceinline__ void gu_item(const Args& a, int r, P0Item& t) {
    const int mtx = r >> 10, rr = r & 1023, e = mtx >> 1, which = mtx & 1, kb = rr >> 6, nb = rr & 63, n0 = 32 * nb;
    t.W = a.in[which == 0 ? 17 : 19] + (size_t)e * D * D; t.g = nullptr; t.N = D; t.ldk = D; t.kofs = 0; t.k0 = 128 * kb; t.n0 = n0; t.q8 = F8_GU;
    t.WT = F8_GU ? (bf16_t*)(a.ws + WS_WGU_T + (size_t)e * 4096 * D) : (bf16_t*)(a.ws + WS_WGU_T) + (size_t)e * 4096 * D;
    t.drow0 = 256 * (n0 >> 7) + (n0 & 127) + (which ? 128 : 0);
}
template<int CNT> __device__ __forceinline__ void convert_gu_chunk(const Args& a, LAS unsigned char* lds, int first) {
    const int lane = threadIdx.x & 63, wave = __builtin_amdgcn_readfirstlane(threadIdx.x >> 6);
    LAS float* scr = (LAS float*)(lds + wave * SCRW);
    LAS float* gl = (LAS float*)(lds + NWAVES * SCRW);
    for (int i = threadIdx.x; i < D; i += NTHREADS) gl[i] = a.in[14][i] * (F8_GU ? 64.f : 1.f);
    __syncthreads();
    const int widx = blockIdx.x * NWAVES + wave;
    if (CNT > 0 && widx < 2048) convert_run<CNT, 1>(scr, gl, lane, [&](int n, P0Item& t) { gu_item(a, first + widx + 2048 * n, t); });
}
__device__ __forceinline__ float sigmoidf_(float x) { return __builtin_amdgcn_rcpf(1.0f + __expf(-x)); }
__device__ __forceinline__ int opaque(int x) { asm volatile("" : "+v"(x)); return x; }

struct EpiProj {
    static constexpr bool HAS_MID = false;
    bf16_t* projb; bf16_t* gates; const float* rope;
    template <bool HU> __device__ __forceinline__ void run(const f32x4 (&acc)[2][2][4][2], const Unit& u, int wr, int wc, int fr, int fq) const {
        const int pn = u.pn, row0 = opaque(u.pm * BM + wr * 64 + fr), colw = wc * 32 + 8 * fq;
        if (pn < 18) {
            const float scale = ((pn < 4 || (pn >= 12 && pn < 16)) ? 0.125f * 1.4426950408889634f : 1.0f) * (F8_P1 ? 0.015625f : 1.0f);
            const bool rope_wave = (pn >= 12 && pn < 17) && ((wc & 1) == 0);
#pragma unroll
            for (int ai = 0; ai < 2; ++ai) if (!HU || u.half != 2 - ai)
#pragma unroll
                for (int m = 0; m < 4; ++m) {
                    const int row = row0 + ai * HALF + m * 16;
                    bf16_t* rowp = projb + (size_t)row * PROJW + pn * BM + colw;
                    f32x4 c0 = {1.f, 1.f, 1.f, 1.f}, c1 = c0, s0 = {0.f, 0.f, 0.f, 0.f}, s1 = s0;
                    if (rope_wave) {
                        const f32x4* rp = (const f32x4*)(rope + (size_t)(row & (SEQ - 1)) * 16);
                        const f32x4 r0 = rp[0], r1 = rp[1], r2 = rp[2], r3 = rp[3];
                        const float sg = (fq == 0) ? -1.f : 1.f; const bool on = fq < 2;
                        c0 = on ? (f32x4){r0[0], r0[2], r1[0], r1[2]} : c0; c1 = on ? (f32x4){r2[0], r2[2], r3[0], r3[2]} : c1;
                        s0 = on ? (f32x4){r0[1], r0[3], r1[1], r1[3]} * sg : s0; s1 = on ? (f32x4){r2[1], r2[3], r3[1], r3[3]} * sg : s1;
                    }
#pragma unroll
                    for (int bj = 0; bj < 2; ++bj) {
                        f32x4 v0 = acc[ai][bj][m][0] * scale, v1 = acc[ai][bj][m][1] * scale;
                        if (rope_wave) {
                            f32x4 p0, p1;
#pragma unroll
                            for (int j = 0; j < 4; ++j) { p0[j] = __shfl_xor(v0[j], 16); p1[j] = __shfl_xor(v1[j], 16); }
                            v0 = v0 * c0 + p0 * s0; v1 = v1 * c1 + p1 * s1;
                        }
                        u32x4 w; w.x = cvt_pk_bf16(v0[0], v0[1]); w.y = cvt_pk_bf16(v0[2], v0[3]); w.z = cvt_pk_bf16(v1[0], v1[1]); w.w = cvt_pk_bf16(v1[2], v1[3]);
                        *(u32x4*)(rowp + bj * HALF) = w;
                    }
                }
        } else {
#pragma unroll
            for (int ai = 0; ai < 2; ++ai) if (!HU || u.half != 2 - ai)
#pragma unroll
                for (int m = 0; m < 4; ++m) {
                    bf16_t* rowp = gates + (size_t)(row0 + ai * HALF + m * 16) * GATEW + (pn - 18) * BM + colw;
#pragma unroll
                    for (int bj = 0; bj < 2; ++bj) {
                        const f32x4 v0 = acc[ai][bj][m][0] * (F8_P1 ? 0.015625f : 1.0f), v1 = acc[ai][bj][m][1] * (F8_P1 ? 0.015625f : 1.0f);
                        u32x4 w; w.x = cvt_pk_bf16(sigmoidf_(v0[0]), sigmoidf_(v0[1])); w.y = cvt_pk_bf16(sigmoidf_(v0[2]), sigmoidf_(v0[3]));
                        w.z = cvt_pk_bf16(sigmoidf_(v1[0]), sigmoidf_(v1[1])); w.w = cvt_pk_bf16(sigmoidf_(v1[2]), sigmoidf_(v1[3]));
                        *(u32x4*)(rowp + bj * HALF) = w;
                    }
                }
        }
    }
};

struct EpiMerge {
    static constexpr bool HAS_MID = true;
    const bf16_t* gates; bf16_t* merged;
    template <bool HU> __device__ __forceinline__ void mid(f32x4 (&acc)[2][2][4][2], const Unit& u, int wr, int wc, int fr, int fq) const {
        const int row0 = opaque(u.pm * BM + wr * 64 + fr), col0 = u.pn * BM + wc * 32 + 8 * fq;
#pragma unroll
        for (int ai = 0; ai < 2; ++ai) if (!HU || u.half != 2 - ai) {
            u32x4 ga[4][2], gb[4][2];
#pragma unroll
            for (int m = 0; m < 4; ++m) { const bf16_t* gp = gates + (size_t)(row0 + ai * HALF + m * 16) * GATEW + col0;
#pragma unroll
                for (int bj = 0; bj < 2; ++bj) { ga[m][bj] = *(const u32x4*)(gp + bj * HALF); gb[m][bj] = *(const u32x4*)(gp + 2048 + bj * HALF); } }
#pragma unroll
            for (int m = 0; m < 4; ++m)
#pragma unroll
                for (int bj = 0; bj < 2; ++bj)
#pragma unroll
                    for (int e = 0; e < 4; ++e) {
                        const float a0 = __uint_as_float(ga[m][bj][e] << 16), a1 = __uint_as_float(ga[m][bj][e] & 0xffff0000u), b0 = __uint_as_float(gb[m][bj][e] << 16), b1 = __uint_as_float(gb[m][bj][e] & 0xffff0000u);
                        acc[ai][bj][m][e >> 1][(e & 1) * 2 + 0] *= a0 * __builtin_amdgcn_rcpf(b0);
                        acc[ai][bj][m][e >> 1][(e & 1) * 2 + 1] *= a1 * __builtin_amdgcn_rcpf(b1);
                    }
            asm volatile("" ::: "memory");
        }
    }
    template <bool HU> __device__ __forceinline__ void run(const f32x4 (&acc)[2][2][4][2], const Unit& u, int wr, int wc, int fr, int fq) const {
        const int row0 = opaque(u.pm * BM + wr * 64 + fr), col0 = u.pn * BM + wc * 32 + 8 * fq;
        u32x4 gb[2][4][2];
#pragma unroll
        for (int ai = 0; ai < 2; ++ai) if (!HU || u.half != 2 - ai)
#pragma unroll
            for (int m = 0; m < 4; ++m)
#pragma unroll
                for (int bj = 0; bj < 2; ++bj) gb[ai][m][bj] = *(const u32x4*)(gates + (size_t)(row0 + ai * HALF + m * 16) * GATEW + 2048 + col0 + bj * HALF);
#pragma unroll
        for (int ai = 0; ai < 2; ++ai) if (!HU || u.half != 2 - ai)
#pragma unroll
            for (int m = 0; m < 4; ++m) {
                bf16_t* op = merged + (size_t)(row0 + ai * HALF + m * 16) * D + col0;
#pragma unroll
                for (int bj = 0; bj < 2; ++bj) {
                    float v[8];
#pragma unroll
                    for (int e = 0; e < 4; ++e) {
                        v[2 * e] = acc[ai][bj][m][e >> 1][(e & 1) * 2] * __uint_as_float(gb[ai][m][bj][e] << 16);
                        v[2 * e + 1] = acc[ai][bj][m][e >> 1][(e & 1) * 2 + 1] * __uint_as_float(gb[ai][m][bj][e] & 0xffff0000u);
                    }
                    u32x4 w; w.x = cvt_pk_bf16(v[0], v[1]); w.y = cvt_pk_bf16(v[2], v[3]); w.z = cvt_pk_bf16(v[4], v[5]); w.w = cvt_pk_bf16(v[6], v[7]);
                    *(u32x4*)(op + bj * HALF) = w;
                }
            }
    }
};

template <bool WB> struct EpiResid {
    static constexpr bool HAS_MID = false;
    const float* xi; float* xo; bf16_t* xob; float* ss;
    template <bool HU> __device__ __forceinline__ void run(const f32x4 (&acc)[2][2][4][2], const Unit& u, int wr, int wc, int fr, int fq) const {
        const int row0 = opaque(u.pm * BM + wr * 64 + fr), col0 = u.pn * BM + wc * 32 + 8 * fq;
#pragma unroll
        for (int ai = 0; ai < 2; ++ai) if (!HU || u.half != 2 - ai) {
            f32x4 r[4][2][2];
#pragma unroll
            for (int m = 0; m < 4; ++m)
#pragma unroll
                for (int bj = 0; bj < 2; ++bj) { const float* p = xi + (size_t)(row0 + ai * HALF + m * 16) * D + col0 + bj * HALF; r[m][bj][0] = *(const f32x4*)p; r[m][bj][1] = *(const f32x4*)(p + 4); }
#pragma unroll
            for (int m = 0; m < 4; ++m) {
                const int row = row0 + ai * HALF + m * 16; const size_t off = (size_t)row * D + col0;
                float q = 0.f;
#pragma unroll
                for (int bj = 0; bj < 2; ++bj) {
                    const f32x4 v0 = r[m][bj][0] + acc[ai][bj][m][0], v1 = r[m][bj][1] + acc[ai][bj][m][1];
                    *(f32x4*)(xo + off + bj * HALF) = v0; *(f32x4*)(xo + off + bj * HALF + 4) = v1;
                    if constexpr (WB) { u32x4 w; w.x = cvt_pk_bf16(v0[0], v0[1]); w.y = cvt_pk_bf16(v0[2], v0[3]); w.z = cvt_pk_bf16(v1[0], v1[1]); w.w = cvt_pk_bf16(v1[2], v1[3]);
                        *(u32x4*)(xob + off + bj * HALF) = w; }
                    q += (v0[0] * v0[0] + v0[1] * v0[1]) + (v0[2] * v0[2] + v0[3] * v0[3]) + (v1[0] * v1[0] + v1[1] * v1[1]) + (v1[2] * v1[2] + v1[3] * v1[3]);
                }
                q += __shfl_xor(q, 16); q += __shfl_xor(q, 32);
                if (fq == 0) atomicAdd(ss + row, q);
            }
        }
    }
};

struct SchedCross {
    static constexpr bool GATHER = false;
    const char* A0; const char* B0; const char* A1; const char* B1; int K, G, c;
    __device__ __forceinline__ bool next(int i, Unit& u) const {
        const int L = i * G + c;
        u.half = 0;
        if (L < 128) { u.e = 0; u.pm = L >> 1; u.pn = L & 1; return true; }
        if (L < 144) { u.e = 1; u.pm = (L - 128) >> 2; u.pn = (L - 128) & 3; return true; }
        return false;
    }
    __device__ __forceinline__ const char* a_base(const Unit& u) const { return (u.e ? A1 : A0) + (size_t)u.pm * BM * K * 2; }
    __device__ __forceinline__ const char* b_base(const Unit& u) const { return (u.e ? B1 : B0) + (size_t)u.pn * BM * K * 2; }
    __device__ __forceinline__ void a_voff(const Unit&, unsigned (&v0)[2], unsigned (&v1)[2], const int (&sR)[2], const int (&sC)[2]) const {
#pragma unroll
        for (int i = 0; i < 2; ++i) { v0[i] = (unsigned)(sR[i] * K + sC[i]) * 2u; v1[i] = (unsigned)((sR[i] + HALF) * K + sC[i]) * 2u; }
    }
};
struct EpiCross {
    static constexpr bool HAS_MID = false;
    const float* ss1; bf16_t* qc; bf16_t* kvc;
    template <bool HU> __device__ __forceinline__ void run(const f32x4 (&acc)[2][2][4][2], const Unit& u, int wr, int wc, int fr, int fq) const {
        const int row0 = opaque(u.pm * BM + wr * 64 + fr), col0 = u.pn * BM + wc * 32 + 8 * fq;
        bf16_t* base = u.e ? kvc : qc; const int ldc = u.e ? 1024 : 512;
        float ssv[2][4];
#pragma unroll
        for (int ai = 0; ai < 2; ++ai) if (!HU || u.half != 2 - ai)
#pragma unroll
            for (int m = 0; m < 4; ++m) ssv[ai][m] = ss1[row0 + ai * HALF + m * 16];
#pragma unroll
        for (int ai = 0; ai < 2; ++ai) if (!HU || u.half != 2 - ai)
#pragma unroll
            for (int m = 0; m < 4; ++m) {
                const int row = row0 + ai * HALF + m * 16;
                const float sc = u.e ? 1.0f : (0.08838834764831845f * 1.4426950408889634f) / sqrtf(ssv[ai][m] * (1.0f / D) + EPS);
                bf16_t* op = base + (size_t)row * ldc + col0;
#pragma unroll
                for (int bj = 0; bj < 2; ++bj) {
                    const f32x4 v0 = acc[ai][bj][m][0] * sc, v1 = acc[ai][bj][m][1] * sc;
                    u32x4 w; w.x = cvt_pk_bf16(v0[0], v0[1]); w.y = cvt_pk_bf16(v0[2], v0[3]); w.z = cvt_pk_bf16(v1[0], v1[1]); w.w = cvt_pk_bf16(v1[2], v1[3]);
                    *(u32x4*)(op + bj * HALF) = w;
                }
            }
    }
};
__device__ __forceinline__ s16x4 ds_tr16(const LAS unsigned char* p) {
    typedef short v4i16_t __attribute__((ext_vector_type(4)));
    return __builtin_bit_cast(s16x4, __builtin_amdgcn_ds_read_tr16_b64_v4i16((LAS v4i16_t*)p));
}
template <int DH> __device__ __forceinline__ int vswz(int key, int q) {
    if (DH == 64) return q ^ (2 * (((key >> 1) & 1) | (((key >> 3) & 1) << 1)));
    return q ^ (2 * ((key & 1) | (((key >> 1) & 1) << 1) | (((key >> 3) & 1) << 2)));
}
template <int DH> __device__ __forceinline__ int kswz(int key, int q) {
#if defined(KSWZ_SIMPLE)
    return q ^ (key & (DH / 8 - 1));
#else
    if (DH == 64) return q ^ (((key >> 1) & 1) | (((key >> 3) & 3) << 1));
    return q ^ ((key & 3) | (((key >> 3) & 3) << 2));
#endif
}
template <int DH> __device__ __forceinline__ void load_q(bf16x8 (&qf)[DH / 32], const bf16_t* __restrict__ Q, int q_pitch, int q_row0, int lane) {
#pragma unroll
    for (int ks = 0; ks < DH / 32; ++ks) qf[ks] = *(const bf16x8*)(Q + (size_t)(q_row0 + (lane & 15)) * q_pitch + ks * 32 + 8 * (lane >> 4));
}
template <int DH, int NCH, bool HAS_SINK, int NRW, class KeyF, class MaskF>
__device__ __forceinline__ void attn_core(const bf16_t* __restrict__ Q, int q_pitch, int q_row0, const LAS unsigned char* kimg, const LAS unsigned char* vimg,
                                          const KeyF& keyf, const MaskF& mb, float sink, bf16_t* __restrict__ O, int o_pitch, int lane, const bf16x8 (&qf)[DH / 32]) {
    constexpr int NKS = DH / 32, NDB = DH / 16, ROWB = DH * 2;
    const int qi = lane & 15, g = lane >> 4;
    f32x4 s[NCH][2];
#pragma unroll
    for (int c = 0; c < NCH; ++c)
#pragma unroll
        for (int tt = 0; tt < 2; ++tt) {
            int key = keyf(c) + 8 * (qi >> 2) + 4 * tt + (qi & 3); if (NRW && key >= NRW) key -= NRW;
            const LAS unsigned char* kr = kimg + key * ROWB;
            f32x4 a = {0.f, 0.f, 0.f, 0.f};
#pragma unroll
            for (int ks = 0; ks < NKS; ++ks) a = __builtin_amdgcn_mfma_f32_16x16x32_bf16(*(const LAS bf16x8*)(kr + 16 * kswz<DH>(key, 4 * ks + g)), qf[ks], a, 0, 0, 0);
            s[c][tt] = a;
            if (tt == 1 && (c & 1)) __builtin_amdgcn_sched_barrier(0);
        }
    float mx = -INFINITY;
#pragma unroll
    for (int c = 0; c < NCH; ++c)
#pragma unroll
        for (int tt = 0; tt < 2; ++tt)
#pragma unroll
            for (int r = 0; r < 4; ++r) { const float v = s[c][tt][r] + mb(c, 8 * g + 4 * tt + r, qi); s[c][tt][r] = v; mx = fmaxf(mx, v); }
    mx = fmaxf(mx, __shfl_xor(mx, 16)); mx = fmaxf(mx, __shfl_xor(mx, 32));
    if (HAS_SINK) mx = fmaxf(mx, sink);
    float sum = 0.f;
    bf16x8 pf[NCH];
#pragma unroll
    for (int c = 0; c < NCH; ++c) {
        float e[8];
#pragma unroll
        for (int tt = 0; tt < 2; ++tt)
#pragma unroll
            for (int r = 0; r < 4; ++r) { const float p = __builtin_amdgcn_exp2f(s[c][tt][r] - mx); e[tt * 4 + r] = p; sum += p; }
        u32x4 w; w.x = cvt_pk_bf16(e[0], e[1]); w.y = cvt_pk_bf16(e[2], e[3]); w.z = cvt_pk_bf16(e[4], e[5]); w.w = cvt_pk_bf16(e[6], e[7]);
        pf[c] = __builtin_bit_cast(bf16x8, w);
    }
    sum += __shfl_xor(sum, 16); sum += __shfl_xor(sum, 32);
    if (HAS_SINK) sum += __builtin_amdgcn_exp2f(sink - mx);
    const float inv = 1.0f / sum;
    f32x4 o[NDB];
#pragma unroll
    for (int db = 0; db < NDB; ++db) o[db] = (f32x4){0.f, 0.f, 0.f, 0.f};
    const int cc = lane & 15;
#pragma unroll
    for (int c = 0; c < NCH; ++c) {
        int k0 = keyf(c) + 8 * g + (cc >> 2), k1 = k0 + 4; if (NRW && k0 >= NRW) k0 -= NRW; if (NRW && k1 >= NRW) k1 -= NRW;
        const LAS unsigned char* r0 = vimg + k0 * ROWB + 8 * (cc & 1); const LAS unsigned char* r1 = vimg + k1 * ROWB + 8 * (cc & 1);
#pragma unroll
        for (int db = 0; db < NDB; ++db) {
            const int q = 2 * db + ((cc & 3) >> 1);
            const s16x4 lo = ds_tr16(r0 + 16 * vswz<DH>(k0, q)), hi = ds_tr16(r1 + 16 * vswz<DH>(k1, q));
            const bf16x8 vf = {lo[0], lo[1], lo[2], lo[3], hi[0], hi[1], hi[2], hi[3]};
            o[db] = __builtin_amdgcn_mfma_f32_16x16x32_bf16(vf, pf[c], o[db], 0, 0, 0);
        }
        if (c & 1) __builtin_amdgcn_sched_barrier(0);
    }
    bf16_t* orow = O + (size_t)(q_row0 + qi) * o_pitch + 4 * g;
#pragma unroll
    for (int db = 0; db < NDB; ++db) { u32x2 w; w.x = cvt_pk_bf16(o[db][0] * inv, o[db][1] * inv); w.y = cvt_pk_bf16(o[db][2] * inv, o[db][3] * inv); *(u32x2*)(orow + 16 * db) = w; }
}

template <int DH, int NROWS> struct Stager {
    static constexpr int CPR = DH / 8, PPI = NROWS * CPR, NP = (2 * PPI + NTHREADS - 1) / NTHREADS, ROWB = DH * 2, IMGB = NROWS * ROWB;
    u32x4 r[NP];
    template <class RowF> __device__ __forceinline__ void load(const bf16_t* __restrict__ Kp, const bf16_t* __restrict__ Vp, int pitch, const RowF& rowf) {
#pragma unroll
        for (int i = 0; i < NP; ++i) { const int p = threadIdx.x + NTHREADS * i; const bool isv = p >= PPI; const int pp = isv ? p - PPI : p, row = pp / CPR, q = pp % CPR;
            if (p < 2 * PPI) r[i] = *(const u32x4*)((isv ? Vp : Kp) + (size_t)rowf(row) * pitch + 8 * q); }
    }
    template <class SlotF> __device__ __forceinline__ void store_slots(LAS unsigned char* kimg, LAS unsigned char* vimg, const SlotF& slotf) const {
#pragma unroll
        for (int i = 0; i < NP; ++i) { const int p = threadIdx.x + NTHREADS * i; const bool isv = p >= PPI; const int pp = isv ? p - PPI : p, row = slotf(pp / CPR), q = pp % CPR;
            if (p < 2 * PPI) *(LAS u32x4*)((isv ? vimg : kimg) + row * ROWB + 16 * (isv ? vswz<DH>(row, q) : kswz<DH>(row, q))) = r[i]; }
    }
    __device__ __forceinline__ void store(LAS unsigned char* kimg, LAS unsigned char* vimg) const {
#pragma unroll
        for (int i = 0; i < NP; ++i) { const int p = threadIdx.x + NTHREADS * i; const bool isv = p >= PPI; const int pp = isv ? p - PPI : p, row = pp / CPR, q = pp % CPR;
            if (p < 2 * PPI) *(LAS u32x4*)((isv ? vimg : kimg) + row * ROWB + 16 * (isv ? vswz<DH>(row, q) : kswz<DH>(row, q))) = r[i]; }
    }
};

__device__ __forceinline__ void p2_attention(const Args& a, LAS unsigned char* lds, int vcu, int G) {
    const int tid = threadIdx.x, lane = tid & 63, wave = __builtin_amdgcn_readfirstlane(tid >> 6);
    unsigned char* ws = a.ws;
    const bf16_t* PROJB = (const bf16_t*)(ws + WS_PROJB); bf16_t* Y = (bf16_t*)(ws + WS_Y);
    constexpr int NUNITS = 2048, UPW_MIN = 8;
    const int upw = ((NUNITS + G - 1) / G + UPW_MIN - 1) / UPW_MIN * UPW_MIN;
    const int u_lo = vcu * upw, u_hi = min(u_lo + upw, NUNITS);
    {
        LAS unsigned char* kimg = lds; LAS unsigned char* vimg = lds + 576 * 128; LAS float* rpl = (LAS float*)(lds + 2 * 576 * 128);
        const int j = wave >> 2, qg = wave & 3, c0 = 16 * qg, w0 = (qg == 0) ? 0 : (qg == 1) ? 8 : (qg == 2) ? 24 : 32;
        u32x4 inc[4];
        int have_hi = -1;
        for (int id = u_lo; id < u_hi; ++id) {
            const int rp = id & 31, h = (id >> 5) & 15, b = id >> 9;
            const int rs0 = min(max(2 * rp - 4, 0), 56);
            const bf16_t* Kg = PROJB + 1024 + h * 64; const bf16_t* Vg = PROJB + 2048 + h * 64;
            const bool fresh = (have_hi < 0) || rp == 0;
            __syncthreads();
            if (fresh) {
                Stager<64, 576> st;
                auto rf = [&](int row) { return b * SEQ + min(rs0 + (row >> 6), 63) * 64 + (row & 63); };
                st.load(Kg, Vg, PROJW, rf);
                auto sf = [&](int row) { return ((rs0 + (row >> 6)) % 9) * 64 + (row & 63); };
                st.store_slots(kimg, vimg, sf);
                if (tid < 465) rpl[tid] = a.in[4][h * 465 + tid] * 1.4426950408889634f;
            } else {
                const int d = rs0 + 9 - have_hi;
#pragma unroll
                for (int i = 0; i < 4; ++i) { const int p = tid + NTHREADS * i; const int isv = p >> 10, rr = (p >> 9) & 1, col = (p >> 3) & 63, q = p & 7;
                    if (rr < d) { const int srow = ((have_hi + rr) % 9) * 64 + col; *(LAS u32x4*)((isv ? vimg : kimg) + srow * 128 + 16 * (isv ? vswz<64>(srow, q) : kswz<64>(srow, q))) = inc[i]; } }
            }
            have_hi = rs0 + 9;
            __syncthreads();
            const int r = 2 * rp + j, rs = min(max(r - 4, 0), 56);
            bf16x8 qf[2]; load_q<64>(qf, PROJB + h * 64, PROJW, b * SEQ + r * 64 + c0, lane);
            __builtin_amdgcn_sched_barrier(0);
            if (id + 1 < u_hi && ((id + 1) & 31) != 0) {
                const int rs0n = min(max(2 * (rp + 1) - 4, 0), 56), dn = rs0n + 9 - have_hi;
#pragma unroll
                for (int i = 0; i < 4; ++i) { const int p = tid + NTHREADS * i; const int isv = p >> 10, rr = (p >> 9) & 1, col = (p >> 3) & 63, q = p & 7;
                    if (rr < dn) inc[i] = *(const u32x4*)((isv ? Vg : Kg) + (size_t)(b * SEQ + min(have_hi + rr, 63) * 64 + col) * PROJW + 8 * q); }
            }
            __builtin_amdgcn_sched_barrier(0);
            const int qc = c0 + (lane & 15), csq = min(max(qc - 8, 0), 48);
            const LAS float* rp_ = rpl + (rs - r + 7) * 31;
            const int m0 = rs % 9;
            auto keyf = [&](int c) { const int m = m0 + c; return (m >= 9 ? m - 9 : m) * 64 + w0; };
            const int relb = w0 - csq, dcb = w0 - qc + 15;
            auto mb = [&](int c, int key, int) { const float bias = rp_[dcb + (c * 31 + key)]; return ((unsigned)(relb + key) < 16u) ? bias : -INFINITY; };
            attn_core<64, 8, false, 0>(PROJB + h * 64, PROJW, b * SEQ + r * 64 + c0, kimg, vimg, keyf, mb, 0.f, Y + h * 64, D, lane, qf);
        }
    }
    __syncthreads();
    {
        LAS unsigned char* kimg = lds; LAS unsigned char* vimg = lds + 320 * 128;
        const int jq = wave >> 2, grp = wave & 3;
        const int isv = tid >> 8, nr = (tid & 255) >> 3, nq = tid & 7;
        u32x4 inc;
        bool have = false;
        for (int id = u_lo; id < u_hi; ++id) {
            const int qb = id & 127, hkv = (id >> 7) & 3, b = id >> 9;
            const bf16_t* Kg = PROJB + 4096 + hkv * 64; const bf16_t* Vg = PROJB + 4352 + hkv * 64;
            const bool fresh = !have || qb == 0;
            __syncthreads();
            if (fresh) {
                Stager<64, 320> st;
                auto rf = [&](int row) { return b * SEQ + min(max(32 * qb - 128 + row, 0), SEQ - 1); };
                st.load(Kg, Vg, PROJW, rf);
                auto sf = [&](int row) { return (32 * qb - 128 + row + 1280) % 320; };
                st.store_slots(kimg, vimg, sf);
            } else {
                const int srow = (32 * qb + 160 + nr + 1280) % 320;
                *(LAS u32x4*)((isv ? vimg : kimg) + srow * 128 + 16 * (isv ? vswz<64>(srow, nq) : kswz<64>(srow, nq))) = inc;
            }
            have = true;
            __syncthreads();
            const int hq = hkv * 4 + grp;
            const int qp0 = 32 * qb + 16 * jq, kp0 = qp0 - 128, qp = qp0 + (lane & 15);
            bf16x8 qf[2]; load_q<64>(qf, PROJB + 3072 + hq * 64, PROJW, b * SEQ + qp0, lane);
            __builtin_amdgcn_sched_barrier(0);
            if (id + 1 < u_hi && ((id + 1) & 127) != 0)
                inc = *(const u32x4*)((isv ? Vg : Kg) + (size_t)(b * SEQ + min(32 * (qb + 1) + 160 + nr, SEQ - 1)) * PROJW + 8 * nq);
            __builtin_amdgcn_sched_barrier(0);
            const int s0 = (kp0 + 1280) % 320;
            auto keyf = [&](int c) { const int m = s0 + 32 * c; return m >= 320 ? m - 320 : m; };
            const int qi_ = lane & 15;
            auto mb = [&](int c, int key, int) { const bool inb = (unsigned)(kp0 + (32 * c + key)) < (unsigned)SEQ; const bool win = (c == 0) ? (key >= qi_) : (c == 8) ? (key <= qi_) : true;
                                                 return (inb && win) ? 0.f : -INFINITY; };
            attn_core<64, 9, true, 320>(PROJB + 3072 + hq * 64, PROJW, b * SEQ + qp0, kimg, vimg, keyf, mb, a.in[5][hq] * 1.4426950408889634f, Y + 1024 + hq * 64, D, lane, qf);
        }
    }
}

__device__ __forceinline__ void p6_cross_attention(const Args& a, LAS unsigned char* lds, int vcu, int G) {
    const int lane = threadIdx.x & 63, wave = __builtin_amdgcn_readfirstlane(threadIdx.x >> 6);
    unsigned char* ws = a.ws;
    const bf16_t* QC = (const bf16_t*)(ws + WS_QC); const bf16_t* KVC = (const bf16_t*)(ws + WS_KVC); bf16_t* OC = (bf16_t*)(ws + WS_OC);
    constexpr int NR = 256;
    LAS unsigned char* kimg = lds; LAS unsigned char* vimg = lds + NR * 256;
    for (int pr = vcu; pr < BATCH * 4 * 16; pr += G) {
        const int qpair = pr & 15, h = (pr >> 4) & 3, b = pr >> 6;
        auto rf = [&](int row) { return b * MEM + row; };
        Stager<128, NR> st;
        st.load(KVC + h * 128, KVC + 512 + h * 128, 1024, rf);
        __syncthreads();
        st.store(kimg, vimg);
        __syncthreads();
        auto keyf = [&](int c) { return 32 * c; };
        auto mb = [&](int, int, int) { return 0.f; };
#pragma unroll 1
        for (int u = 0; u < 2; ++u) {
            bf16x8 qf[4]; load_q<128>(qf, QC + h * 128, 512, b * SEQ + (qpair * 2 + u) * 128 + wave * 16, lane);
            attn_core<128, 8, false, 0>(QC + h * 128, 512, b * SEQ + (qpair * 2 + u) * 128 + wave * 16, kimg, vimg, keyf, mb, 0.f, OC + h * 128, 512, lane, qf);
        }
    }
}
__device__ __forceinline__ void p8_router(const Args& a, LAS unsigned char* lds, int vcu, int G) {
    const int tid = threadIdx.x, lane = tid & 63, wave = __builtin_amdgcn_readfirstlane(tid >> 6);
    unsigned char* ws = a.ws;
    const float* X2 = (const float*)(ws + WS_X1); const float* WRG = (const float*)(ws + WS_WRG); const float* SS2 = (const float*)(ws + WS_SS2);
    int* cnt = (int*)(ws + WS_CTL) + CW_CNT; int* TE = (int*)(ws + WS_TE); int* TP = (int*)(ws + WS_TP); float* TW = (float*)(ws + WS_TW); int* LIST = (int*)(ws + WS_LIST);
    LAS float* part = (LAS float*)lds;
    const int tg = wave & 1, kq = wave >> 1;
    for (int blk = vcu; blk < T / 64; blk += G) {
        const int tok0 = blk * 64 + tg * 32;
        f32x16 acc;
#pragma unroll
        for (int i = 0; i < 16; ++i) acc[i] = 0.f;
        const float* xr = X2 + (size_t)(tok0 + (lane & 31)) * D + kq * 512 + 4 * (lane >> 5);
        const float* wr = WRG + (size_t)(kq * 512 + 4 * (lane >> 5)) * NE + (lane & 31);
#pragma unroll 4
        for (int k0 = 0; k0 < 512; k0 += 8) {
            const f32x4 xa = *(const f32x4*)(xr + k0);
            const float b0 = wr[(size_t)(k0 + 0) * NE], b1 = wr[(size_t)(k0 + 1) * NE], b2 = wr[(size_t)(k0 + 2) * NE], b3 = wr[(size_t)(k0 + 3) * NE];
            acc = __builtin_amdgcn_mfma_f32_32x32x2f32(xa[0], b0, acc, 0, 0, 0);
            acc = __builtin_amdgcn_mfma_f32_32x32x2f32(xa[1], b1, acc, 0, 0, 0);
            acc = __builtin_amdgcn_mfma_f32_32x32x2f32(xa[2], b2, acc, 0, 0, 0);
            acc = __builtin_amdgcn_mfma_f32_32x32x2f32(xa[3], b3, acc, 0, 0, 0);
        }
#pragma unroll
        for (int r = 0; r < 16; ++r) part[(wave * 32 + (r & 3) + 8 * (r >> 2) + 4 * (lane >> 5)) * 33 + (lane & 31)] = acc[r];
        __syncthreads();
        if (tid < 64) {
            const int tl = tid & 31, g2 = tid >> 5, tok = blk * 64 + tid;
            const float rstd = 1.0f / sqrtf(SS2[tok] * (1.0f / D) + EPS);
            float v0 = -INFINITY, v1 = -INFINITY, v2 = -INFINITY, v3 = -INFINITY; int i0 = 0, i1 = 0, i2 = 0, i3 = 0;
#pragma unroll
            for (int e = 0; e < NE; ++e) {
                float l = 0.f;
#pragma unroll
                for (int q = 0; q < 4; ++q) l += part[((q * 2 + g2) * 32 + tl) * 33 + e];
                l = l * rstd + a.in[16][e];
                if (l > v3) {
                    if (l > v2) { v3 = v2; i3 = i2; if (l > v1) { v2 = v1; i2 = i1; if (l > v0) { v1 = v0; i1 = i0; v0 = l; i0 = e; } else { v1 = l; i1 = e; } } else { v2 = l; i2 = e; } }
                    else { v3 = l; i3 = e; }
                }
            }
            const float w0 = 1.0f, w1 = expf(v1 - v0), w2 = expf(v2 - v0), w3 = expf(v3 - v0), inv = 1.0f / (w0 + w1 + w2 + w3);
            const int p0 = atomicAdd(cnt + i0, 1), p1 = atomicAdd(cnt + i1, 1), p2 = atomicAdd(cnt + i2, 1), p3 = atomicAdd(cnt + i3, 1);
            LIST[(size_t)i0 * T + p0] = tok; LIST[(size_t)i1 * T + p1] = tok; LIST[(size_t)i2 * T + p2] = tok; LIST[(size_t)i3 * T + p3] = tok;
            *(int4*)(TE + tok * 4) = make_int4(i0, i1, i2, i3); *(int4*)(TP + tok * 4) = make_int4(p0, p1, p2, p3);
            *(float4*)(TW + tok * 4) = make_float4(w0 * inv, w1 * inv, w2 * inv, w3 * inv);
        }
        __syncthreads();
    }
    {
        bf16_t* X2B = (bf16_t*)(ws + WS_XB);
        const int gw = vcu * NWAVES + wave, NGW = G * NWAVES;
        for (int m = gw; m < T; m += NGW) {
            const float rstd = 1.0f / sqrtf(SS2[m] * (1.0f / D) + EPS);
            const f32x4* xr = (const f32x4*)(X2 + (size_t)m * D) + lane;
            f32x4 v[8];
#pragma unroll
            for (int j = 0; j < 8; ++j) v[j] = xr[64 * j];
            if (F8_GU) { unsigned* o4 = (unsigned*)((unsigned char*)X2B + (size_t)m * D) + lane;
#pragma unroll
                for (int j = 0; j < 8; ++j) o4[64 * j] = pk4_fp8(v[j][0] * rstd, v[j][1] * rstd, v[j][2] * rstd, v[j][3] * rstd);
            } else { u32x2* o8 = (u32x2*)(X2B + (size_t)m * D) + lane;
#pragma unroll
                for (int j = 0; j < 8; ++j) { u32x2 o; o.x = cvt_pk_bf16(v[j][0] * rstd, v[j][1] * rstd); o.y = cvt_pk_bf16(v[j][2] * rstd, v[j][3] * rstd); o8[64 * j] = o; } }
        }
    }
}

__device__ __forceinline__ void moe_tile_table(const Args& a, volatile LAS unsigned* MISC) {
    if (threadIdx.x == 0) {
        const int* cnt = (const int*)(a.ws + WS_CTL) + CW_CNT; unsigned acc = 0;
        for (int e = 0; e < NE; ++e) { const int c = __hip_atomic_load(cnt + e, __ATOMIC_RELAXED, __HIP_MEMORY_SCOPE_AGENT); MISC[32 + e] = acc; MISC[96 + e] = (unsigned)c; acc += (unsigned)((c + 255) >> 8); }
        MISC[64] = acc;
    }
    __syncthreads();
}
#ifndef WGM_GU
#define WGM_GU 4
#endif
#ifndef WGM_DN
#define WGM_DN 4
#endif
template <bool GU> struct SchedMoE {
    static constexpr bool GATHER = GU;
    const char* A; const char* Bt; const int* list; volatile LAS unsigned* MISC; int K, nM, nN, G, c;
    __device__ __forceinline__ bool next(int i, Unit& u) const {
        if (!static_order<GU ? WGM_GU : WGM_DN>(nM, nN, G, c, i, u.pm, u.pn, u.half)) return false;
        int e = 0;
#pragma unroll
        for (int k = 1; k < NE; ++k) e += ((unsigned)u.pm >= MISC[32 + k]) ? 1 : 0;
        u.e = __builtin_amdgcn_readfirstlane(e); return true;
    }
    __device__ __forceinline__ const char* a_base(const Unit& u) const { return GU ? A : A + (size_t)u.pm * BM * K * 2; }
    __device__ __forceinline__ const char* b_base(const Unit& u) const { return Bt + ((size_t)u.e * (GU ? 4096 : 2048) + (size_t)u.pn * BM) * K * 2; }
    __device__ __forceinline__ void a_voff(const Unit& u, unsigned (&v0)[2], unsigned (&v1)[2], const int (&sR)[2], const int (&sC)[2]) const {
        if (GU) {
            const int lt = u.pm - (int)MISC[32 + u.e], n = (int)MISC[96 + u.e]; const int* le = list + (size_t)u.e * T;
#pragma unroll
            for (int i = 0; i < 2; ++i) { const int r0 = lt * BM + sR[i], r1 = r0 + HALF; const int t0 = le[r0 < n ? r0 : 0], t1 = le[r1 < n ? r1 : 0];
                v0[i] = (unsigned)(t0 * K + sC[i]) * 2u; v1[i] = (unsigned)(t1 * K + sC[i]) * 2u; }
        } else {
#pragma unroll
            for (int i = 0; i < 2; ++i) { v0[i] = (unsigned)(sR[i] * K + sC[i]) * 2u; v1[i] = (unsigned)((sR[i] + HALF) * K + sC[i]) * 2u; }
        }
    }
};
struct EpiGU {
    static constexpr bool HAS_MID = false;
    const float* bg; const float* bu; bf16_t* act;
    template <bool HU> __device__ __forceinline__ void run(const f32x4 (&acc)[2][2][4][2], const Unit& u, int wr, int wc, int fr, int fq) const {
        const int row0 = opaque(u.pm * BM + wr * 64 + fr), f0 = u.pn * HALF + wc * 32 + 8 * fq;
        const f32x4 bg0 = *(const f32x4*)(bg + (size_t)u.e * D + f0), bg1 = *(const f32x4*)(bg + (size_t)u.e * D + f0 + 4);
        const f32x4 bu0 = *(const f32x4*)(bu + (size_t)u.e * D + f0) + 1.0f, bu1 = *(const f32x4*)(bu + (size_t)u.e * D + f0 + 4) + 1.0f;
#pragma unroll
        for (int ai = 0; ai < 2; ++ai) if (!HU || u.half != 2 - ai)
#pragma unroll
            for (int m = 0; m < 4; ++m) {
                f32x4 o[2];
#pragma unroll
                for (int nn = 0; nn < 2; ++nn) {
                    f32x4 gv = acc[ai][0][m][nn] * (F8_GU ? 0.015625f : 1.0f) + (nn ? bg1 : bg0), uv1 = acc[ai][1][m][nn] * (F8_GU ? 0.015625f : 1.0f) + (nn ? bu1 : bu0);
                    gv = __builtin_elementwise_min(gv, (f32x4){7.f, 7.f, 7.f, 7.f});
                    uv1 = __builtin_elementwise_min(__builtin_elementwise_max(uv1, (f32x4){-6.f, -6.f, -6.f, -6.f}), (f32x4){8.f, 8.f, 8.f, 8.f});
                    const f32x4 t = gv * (-1.702f * 1.4426950408889634f);
                    f32x4 dn; dn[0] = __builtin_amdgcn_exp2f(t[0]); dn[1] = __builtin_amdgcn_exp2f(t[1]); dn[2] = __builtin_amdgcn_exp2f(t[2]); dn[3] = __builtin_amdgcn_exp2f(t[3]);
                    dn = dn + 1.0f;
                    f32x4 rc; rc[0] = __builtin_amdgcn_rcpf(dn[0]); rc[1] = __builtin_amdgcn_rcpf(dn[1]); rc[2] = __builtin_amdgcn_rcpf(dn[2]); rc[3] = __builtin_amdgcn_rcpf(dn[3]);
                    o[nn] = (uv1 * gv) * rc;
                }
                if (F8_DN) { u32x2 w8; w8.x = pk4_fp8(o[0][0], o[0][1], o[0][2], o[0][3]); w8.y = pk4_fp8(o[1][0], o[1][1], o[1][2], o[1][3]);
                    *(u32x2*)((unsigned char*)act + (size_t)(row0 + ai * HALF + m * 16) * D + f0) = w8; }
                else { u32x4 w; w.x = cvt_pk_bf16(o[0][0], o[0][1]); w.y = cvt_pk_bf16(o[0][2], o[0][3]); w.z = cvt_pk_bf16(o[1][0], o[1][1]); w.w = cvt_pk_bf16(o[1][2], o[1][3]);
                    *(u32x4*)(act + (size_t)(row0 + ai * HALF + m * 16) * D + f0) = w; }
            }
    }
};
struct EpiDown {
    static constexpr bool HAS_MID = false;
    const float* bd; bf16_t* y;
    template <bool HU> __device__ __forceinline__ void run(const f32x4 (&acc)[2][2][4][2], const Unit& u, int wr, int wc, int fr, int fq) const {
        const int row0 = opaque(u.pm * BM + wr * 64 + fr), col0 = u.pn * BM + wc * 32 + 8 * fq;
        f32x4 b[2][2];
#pragma unroll
        for (int bj = 0; bj < 2; ++bj) { b[bj][0] = *(const f32x4*)(bd + (size_t)u.e * D + col0 + bj * HALF); b[bj][1] = *(const f32x4*)(bd + (size_t)u.e * D + col0 + bj * HALF + 4); }
#pragma unroll
        for (int ai = 0; ai < 2; ++ai) if (!HU || u.half != 2 - ai)
#pragma unroll
            for (int m = 0; m < 4; ++m) {
                bf16_t* op = y + (size_t)(row0 + ai * HALF + m * 16) * D + col0;
#pragma unroll
                for (int bj = 0; bj < 2; ++bj) {
                    const f32x4 v0 = acc[ai][bj][m][0] * (F8_DN ? 0.015625f : 1.0f) + b[bj][0], v1 = acc[ai][bj][m][1] * (F8_DN ? 0.015625f : 1.0f) + b[bj][1];
                    if (F8_Y) { u32x2 w8; w8.x = pk4_fp8(v0[0], v0[1], v0[2], v0[3]); w8.y = pk4_fp8(v1[0], v1[1], v1[2], v1[3]);
                        *(u32x2*)((unsigned char*)y + (size_t)(row0 + ai * HALF + m * 16) * D + col0 + bj * HALF) = w8; }
                    else { u32x4 w; w.x = cvt_pk_bf16(v0[0], v0[1]); w.y = cvt_pk_bf16(v0[2], v0[3]); w.z = cvt_pk_bf16(v1[0], v1[1]); w.w = cvt_pk_bf16(v1[2], v1[3]);
                        *(u32x4*)(op + bj * HALF) = w; }
                }
            }
    }
};
__device__ __forceinline__ void p11_final(const Args& a, volatile LAS unsigned* MISC, int vcu, int G) {
    const int lane = threadIdx.x & 63, wave = __builtin_amdgcn_readfirstlane(threadIdx.x >> 6);
    unsigned char* ws = a.ws;
    const float* X2 = (const float*)(ws + WS_X1); const bf16_t* Y = (const bf16_t*)(ws + WS_YMOE);
    const int* TE = (const int*)(ws + WS_TE); const int* TP = (const int*)(ws + WS_TP); const float* TW = (const float*)(ws + WS_TW);
    const int gw = vcu * NWAVES + wave, NGW = G * NWAVES;
    for (int tok = gw; tok < T; tok += NGW) {
        const int4 te = *(const int4*)(TE + tok * 4), tp = *(const int4*)(TP + tok * 4); const float4 tw = *(const float4*)(TW + tok * 4);
        const size_t r0 = (size_t)MISC[32 + te.x] * BM + tp.x, r1 = (size_t)MISC[32 + te.y] * BM + tp.y, r2 = (size_t)MISC[32 + te.z] * BM + tp.z, r3 = (size_t)MISC[32 + te.w] * BM + tp.w;
        f32x4 v[4][2]; float ss = 0.f;
#pragma unroll
        for (int jj = 0; jj < 4; ++jj) {
            const int c = 8 * (lane + 64 * jj);
            const f32x4 x0 = *(const f32x4*)(X2 + (size_t)tok * D + c), x1 = *(const f32x4*)(X2 + (size_t)tok * D + c + 4);
            float o[8];
            if (F8_Y) {
                const unsigned char* Y8 = (const unsigned char*)Y;
                const u32x2 y0 = *(const u32x2*)(Y8 + r0 * D + c), y1 = *(const u32x2*)(Y8 + r1 * D + c), y2 = *(const u32x2*)(Y8 + r2 * D + c), y3 = *(const u32x2*)(Y8 + r3 * D + c);
#pragma unroll
                for (int e = 0; e < 2; ++e)
#pragma unroll
                    for (int hw = 0; hw < 2; ++hw) {
                        const f32x2 a0 = hw ? __builtin_amdgcn_cvt_pk_f32_fp8((int)y0[e], true) : __builtin_amdgcn_cvt_pk_f32_fp8((int)y0[e], false), a1 = hw ? __builtin_amdgcn_cvt_pk_f32_fp8((int)y1[e], true) : __builtin_amdgcn_cvt_pk_f32_fp8((int)y1[e], false);
                        const f32x2 a2 = hw ? __builtin_amdgcn_cvt_pk_f32_fp8((int)y2[e], true) : __builtin_amdgcn_cvt_pk_f32_fp8((int)y2[e], false), a3 = hw ? __builtin_amdgcn_cvt_pk_f32_fp8((int)y3[e], true) : __builtin_amdgcn_cvt_pk_f32_fp8((int)y3[e], false);
                        o[4 * e + 2 * hw] = tw.x * a0[0] + tw.y * a1[0] + tw.z * a2[0] + tw.w * a3[0]; o[4 * e + 2 * hw + 1] = tw.x * a0[1] + tw.y * a1[1] + tw.z * a2[1] + tw.w * a3[1];
                    }
            } else {
            const u32x4 y0 = *(const u32x4*)(Y + r0 * D + c), y1 = *(const u32x4*)(Y + r1 * D + c), y2 = *(const u32x4*)(Y + r2 * D + c), y3 = *(const u32x4*)(Y + r3 * D + c);
#pragma unroll
            for (int e = 0; e < 4; ++e) {
                o[2 * e] = tw.x * __uint_as_float(y0[e] << 16) + tw.y * __uint_as_float(y1[e] << 16) + tw.z * __uint_as_float(y2[e] << 16) + tw.w * __uint_as_float(y3[e] << 16);
                o[2 * e + 1] = tw.x * __uint_as_float(y0[e] & 0xffff0000u) + tw.y * __uint_as_float(y1[e] & 0xffff0000u) + tw.z * __uint_as_float(y2[e] & 0xffff0000u) + tw.w * __uint_as_float(y3[e] & 0xffff0000u);
            }
            }
            v[jj][0] = x0 + (f32x4){o[0], o[1], o[2], o[3]}; v[jj][1] = x1 + (f32x4){o[4], o[5], o[6], o[7]};
#pragma unroll
            for (int h = 0; h < 2; ++h) ss += (v[jj][h][0] * v[jj][h][0] + v[jj][h][1] * v[jj][h][1]) + (v[jj][h][2] * v[jj][h][2] + v[jj][h][3] * v[jj][h][3]);
        }
        const float rstd = 1.0f / sqrtf(wave_sum(ss) * (1.0f / D) + EPS);
#pragma unroll
        for (int jj = 0; jj < 4; ++jj) {
            const int c = 8 * (lane + 64 * jj);
            const f32x4 g0 = *(const f32x4*)(a.in[23] + c), g1 = *(const f32x4*)(a.in[23] + c + 4);
            *(f32x4*)(a.out + (size_t)tok * D + c) = v[jj][0] * rstd * g0; *(f32x4*)(a.out + (size_t)tok * D + c + 4) = v[jj][1] * rstd * g1;
        }
    }
}
#ifndef STEAL_P1
#define STEAL_P1 4
#endif
#ifndef STEAL_P5
#define STEAL_P5 9
#endif
#ifndef HD3
#define HD3 2
#endif
#ifndef HD4
#define HD4 2
#endif
#ifndef HD7
#define HD7 2
#endif
#define DQ_P3 (1024 * STEAL_P1)
#define DQ_P4 (DQ_P3 + 2048 * HD3)
#define DQ_P5 (DQ_P4 + 2048 * HD4)
#define DQ_P7 (DQ_P5 + 896 * STEAL_P5)
#define DQ_P9 (DQ_P7 + 2048 * HD7)
static_assert(DQ_P9 <= NE * 1024 && (NE * 1024 - DQ_P9) % 4 == 0, "w_down queue");
#define HOST_DOWN(first, n) do { if (G == 256) convert_down_static<(n)>(args, lds, (first), bx * NWAVES + (tid >> 6), 2048); } while (0)
__global__ void __launch_bounds__(NTHREADS, 2) mk_fwd(Args args) {
    extern __shared__ __attribute__((aligned(16))) unsigned char lds_raw[];
    LAS unsigned char* lds = (LAS unsigned char*)lds_raw;
    volatile LAS unsigned* MISC = (volatile LAS unsigned*)(lds + MISC_OFF);
    const int tid = threadIdx.x;
    const int G = gridDim.x; const int bx = blockIdx.x; const int vcu = (G % 8 == 0) ? (bx % 8) * (G / 8) + bx / 8 : bx;
    unsigned char* ws = args.ws;
    if (tid < 256) MISC[tid] = 0u;
    __syncthreads();
    const int lo = args.ph_lo, hi = args.ph_hi;
    const bool use_bar = (hi - lo) > 1;
    XcdBarrier bar; bar.bar = (unsigned*)(ws + WS_CTL); bar.x = 0; bar.st = nullptr;
    if (use_bar) bar = xcd_barrier_post((unsigned*)(ws + WS_CTL), MISC + 8);
#define IN(k) (lo <= (k) && (k) < hi)
#define SEAM(k) do { if (IN(k) && IN((k) + 1)) xcd_barrier(bar); } while (0)

    if (IN(0)) { p0_prologue(args, lds, vcu, G); __syncthreads(); }
    SEAM(0);
    if (IN(1)) {
        constexpr int KB = F8_P1 ? D / 2 : D;
        SchedPlain S{(const char*)(ws + WS_XB), (const char*)(ws + WS_WIN_T), KB, T / BM, DIN / BM, G, bx};
        EpiProj E{(bf16_t*)(ws + WS_PROJB), (bf16_t*)(ws + WS_GATES), (const float*)(ws + WS_ROPE)};
        gemm_phase<EpiProj, SchedPlain, 0, F8_P1 != 0>(lds, KB, S, E);
        if (G == 256 && bx >= 128) convert_down_static<STEAL_P1>(args, lds, 0, (bx - 128) * NWAVES + (tid >> 6), 1024);
    }
    SEAM(1);
    if (IN(2)) { p2_attention(args, lds, vcu, G); __syncthreads(); }
    SEAM(2);
    if (IN(3)) {
        SchedPlain S{(const char*)(ws + WS_Y), (const char*)(ws + WS_WOA_T), D, T / BM, D / BM, G, bx};
        EpiMerge E{(const bf16_t*)(ws + WS_GATES), (bf16_t*)(ws + WS_MERGED)};
        if (bx & 1) { convert_gu_chunk<DEFER_N3>(args, lds, GU_P0_TILES); HOST_DOWN(DQ_P3, HD3); __syncthreads(); }
        gemm_phase<EpiMerge, SchedPlain>(lds, D, S, E);
        if (!(bx & 1)) { convert_gu_chunk<DEFER_N3>(args, lds, GU_P0_TILES); HOST_DOWN(DQ_P3, HD3); }
    }
    SEAM(3);
    if (IN(4)) {
        SchedPlain S{(const char*)(ws + WS_MERGED), (const char*)(ws + WS_WOUT_T), D, T / BM, D / BM, G, bx};
        EpiResid<true> E{args.in[0], (float*)(ws + WS_X1), (bf16_t*)(ws + WS_XB), (float*)(ws + WS_SS1)};
        if (bx & 1) { convert_gu_chunk<DEFER_N4>(args, lds, GU_P0_TILES + 2048 * DEFER_N3); HOST_DOWN(DQ_P4, HD4); __syncthreads(); }
        gemm_phase<EpiResid<true>, SchedPlain>(lds, D, S, E);
        if (!(bx & 1)) { convert_gu_chunk<DEFER_N4>(args, lds, GU_P0_TILES + 2048 * DEFER_N3); HOST_DOWN(DQ_P4, HD4); }
    }
    SEAM(4);
    if (IN(5)) {
        SchedCross S{(const char*)(ws + WS_XB), (const char*)(ws + WS_WCQ_T), (const char*)(ws + WS_MEMB), (const char*)(ws + WS_WCKV_T), D, G, bx};
        EpiCross E{(const float*)(ws + WS_SS1), (bf16_t*)(ws + WS_QC), (bf16_t*)(ws + WS_KVC)};
        gemm_phase<EpiCross, SchedCross>(lds, D, S, E);
        if (G == 256 && bx >= 144) convert_down_static<STEAL_P5>(args, lds, DQ_P5, (bx - 144) * NWAVES + (tid >> 6), 896);
    }
    SEAM(5);
    if (IN(6)) { p6_cross_attention(args, lds, vcu, G); __syncthreads(); }
    SEAM(6);
    if (IN(7)) {
        SchedPlain S{(const char*)(ws + WS_OC), (const char*)(ws + WS_WCO_T), 512, T / BM, D / BM, G, bx};
        EpiResid<false> E{(const float*)(ws + WS_X1), (float*)(ws + WS_X1), nullptr, (float*)(ws + WS_SS2)};
        if (bx & 1) { convert_gu_chunk<DEFER_N7>(args, lds, GU_P0_TILES + 2048 * (DEFER_N3 + DEFER_N4)); HOST_DOWN(DQ_P7, HD7); __syncthreads(); }
        gemm_phase<EpiResid<false>, SchedPlain>(lds, 512, S, E);
        if (!(bx & 1)) { convert_gu_chunk<DEFER_N7>(args, lds, GU_P0_TILES + 2048 * (DEFER_N3 + DEFER_N4)); HOST_DOWN(DQ_P7, HD7); }
    }
    SEAM(7);
    if (IN(8)) { p8_router(args, lds, vcu, G); }
    SEAM(8);
    if (IN(9)) {
        moe_tile_table(args, MISC);
        constexpr int KB = F8_GU ? D / 2 : D;
        SchedMoE<true> S{(const char*)(ws + WS_XB), (const char*)(ws + WS_WGU_T), (const int*)(ws + WS_LIST), MISC, KB, (int)MISC[64], 16, G, bx};
        EpiGU E{args.in[18], args.in[20], (bf16_t*)(ws + WS_ACT)};
        gemm_phase<EpiGU, SchedMoE<true>, 0, F8_GU != 0>(lds, KB, S, E);
        convert_down_drain(args, lds, G == 256 ? DQ_P9 : 0);
    }
    SEAM(9);
    if (IN(10)) {
        moe_tile_table(args, MISC);
        constexpr int KB = F8_DN ? D / 2 : D;
        SchedMoE<false> S{(const char*)(ws + WS_ACT), (const char*)(ws + WS_WD_T), nullptr, MISC, KB, (int)MISC[64], 8, G, bx};
        EpiDown E{args.in[22], (bf16_t*)(ws + WS_YMOE)};
        gemm_phase<EpiDown, SchedMoE<false>, 0, F8_DN != 0>(lds, KB, S, E);
    }
    SEAM(10);
    if (IN(11)) { moe_tile_table(args, MISC); p11_final(args, MISC, vcu, G); }
#undef IN
#undef SEAM
}

extern "C" void kernel_launch(void* const* d_in, const int* in_sizes, int n_in, void* d_out, int out_size, void* d_ws, size_t ws_size, hipStream_t stream) {
    static int grid = 0;
    if (grid == 0) {
        int dev = 0, cus = 0;
        if (hipGetDevice(&dev) != hipSuccess || hipDeviceGetAttribute(&cus, hipDeviceAttributeMultiprocessorCount, dev) != hipSuccess) { grid = -1; return; }
        if (hipFuncSetAttribute((const void*)mk_fwd, hipFuncAttributeMaxDynamicSharedMemorySize, LDS_BYTES) != hipSuccess) { grid = -1; return; }
        int per_cu = 0;
        if (hipOccupancyMaxActiveBlocksPerMultiprocessor(&per_cu, (const void*)mk_fwd, NTHREADS, LDS_BYTES) != hipSuccess || per_cu < 1) { grid = -1; return; }
        (void)hipGetLastError();
        grid = cus;
    }
    if (grid < 0 || ws_size < WS_END) return;
    float* out = (float*)d_out;
    unsigned char* ws = (unsigned char*)d_ws;
    (void)hipMemsetAsync(ws + WS_CTL, 0, WS_ZERO_BYTES, stream);
    Args a{};
    for (int i = 0; i < 24; ++i) a.in[i] = (const float*)d_in[i];
    a.out = out; a.ws = ws;
    a.ph_lo = 0; a.ph_hi = 12;
    hipLaunchKernelGGL(mk_fwd, dim3(grid), dim3(NTHREADS), LDS_BYTES, stream, a);
}
```

```cpp
#include <hip/hip_runtime.h>
#include <math.h>
#include <stdint.h>

#define LAS __attribute__((address_space(3)))
#define GAS __attribute__((address_space(1)))
typedef unsigned short bf16_t;
typedef short bf16x8 __attribute__((ext_vector_type(8)));
typedef short s16x4 __attribute__((ext_vector_type(4)));
typedef float f32x4 __attribute__((ext_vector_type(4)));
typedef float f32x2 __attribute__((ext_vector_type(2)));
typedef float f32x16 __attribute__((ext_vector_type(16)));
typedef unsigned u32x4 __attribute__((ext_vector_type(4)));
typedef unsigned u32x2 __attribute__((ext_vector_type(2)));

constexpr int D = 2048, BATCH = 4, SEQ = 4096, T = BATCH * SEQ, MEM = 256, NMEM = BATCH * MEM, DIN = 8704;
constexpr int NE = 32, TOPK = 4, NASSIGN = T * TOPK;
constexpr int PROJW = 4608;
constexpr int GATEW = 4096;
constexpr int MAXTILES = 288;
constexpr float EPS = 1e-5f;
constexpr int NWAVES = 8, NTHREADS = 512;
constexpr int LDS_BYTES = 155648;
constexpr int MISC_OFF = 155648 - 1024;

__device__ __forceinline__ float bf2f(bf16_t v) { return __uint_as_float((unsigned)v << 16); }
__device__ __forceinline__ unsigned f2bf(float f) { unsigned u = __float_as_uint(f); return (u + 0x7fffu + ((u >> 16) & 1u)) >> 16; }
__device__ __forceinline__ unsigned pk2(float lo, float hi) { return f2bf(lo) | (f2bf(hi) << 16); }
typedef __bf16 bf16x2_t __attribute__((ext_vector_type(2)));
__device__ __forceinline__ unsigned cvt_pk_bf16(float lo, float hi) { const f32x2 v = {lo, hi}; const bf16x2_t b = __builtin_convertvector(v, bf16x2_t); return __builtin_bit_cast(unsigned, b); }
__device__ __forceinline__ float wave_sum(float v) {
#pragma unroll
    for (int o = 1; o < 64; o <<= 1) v += __shfl_xor(v, o);
    return v;
}
typedef int v8i32 __attribute__((ext_vector_type(8)));
typedef int i32x4 __attribute__((ext_vector_type(4)));
__device__ __forceinline__ float clamp448(float x) { return fminf(fmaxf(x, -448.0f), 448.0f); }
__device__ __forceinline__ unsigned pk4_fp8(float a, float b, float c, float d) {
    int p = __builtin_amdgcn_cvt_pk_fp8_f32(clamp448(a), clamp448(b), 0, false);
    p = __builtin_amdgcn_cvt_pk_fp8_f32(clamp448(c), clamp448(d), p, true);
    return (unsigned)p;
}
#define LDS_WAIT() asm volatile("s_waitcnt lgkmcnt(0)" ::: "memory")
#define VM_WAIT() asm volatile("s_waitcnt vmcnt(0)" ::: "memory")

#define XB_TMO      128
#define XB_XCNT(j)  (256  + 64 * (j))
#define XB_XSUB(j)  (1280 + 64 * (j))
#define XB_XGEN(j)  (2304 + 64 * (j))
#define XB_TOP      3328
#define XB_TOPGEN   3392
#define XCD_BAR_WORDS 3456
#define XB_SPIN_CAP (1u << 18)

__device__ __forceinline__ unsigned xb_ld(unsigned* p)              { return __hip_atomic_load(p, __ATOMIC_RELAXED, __HIP_MEMORY_SCOPE_AGENT); }
__device__ __forceinline__ unsigned xb_add(unsigned* p, unsigned v) { return __hip_atomic_fetch_add(p, v, __ATOMIC_RELAXED, __HIP_MEMORY_SCOPE_AGENT); }
__device__ __forceinline__ unsigned xb_xcc_id() { return (unsigned)__builtin_amdgcn_s_getreg((3 << 11) | 20) & 0xFu; }
#define XB_SPIN(cond, bar) do { unsigned _sp = 0; while (cond) { __builtin_amdgcn_s_sleep(1); \
    if ((++_sp & 255u) == 0u) { if (xb_ld(&(bar)[XB_TMO])) break; if (_sp > XB_SPIN_CAP) { atomicAdd(&(bar)[XB_TMO], 1u); break; } } } } while (0)

struct XcdBarrier {
    unsigned* bar; unsigned x;
    volatile LAS unsigned* st;
};
__device__ __forceinline__ XcdBarrier xcd_barrier_post(unsigned* bar, volatile LAS unsigned* st) {
    XcdBarrier b; b.bar = bar; b.x = xb_xcc_id(); b.st = st;
    if (threadIdx.x == 0) (void)xb_add(&bar[XB_XCNT(b.x)], 1u);
    return b;
}
__device__ __forceinline__ void xcd_barrier_complete(unsigned* bar, unsigned x, unsigned& nloc, unsigned& nx) {
    const unsigned G = gridDim.x * gridDim.y * gridDim.z;
    unsigned sum, cnt, mine, sp = 0u;
    for (;;) {
        sum = 0u; cnt = 0u; mine = 0u;
#pragma unroll
        for (unsigned j = 0; j < 16; ++j) { const unsigned c = xb_ld(&bar[XB_XCNT(j)]); sum += c; cnt += (c > 0u) ? 1u : 0u; mine = (j == x) ? c : mine; }
        if (sum == G) break;
        __builtin_amdgcn_s_sleep(1);
        if ((++sp & 255u) == 0u) { if (xb_ld(&bar[XB_TMO])) break; if (sp > XB_SPIN_CAP) { atomicAdd(&bar[XB_TMO], 1u); break; } }
    }
    nloc = mine > 0u ? mine : 1u; nx = cnt > 0u ? cnt : 1u;
}
__device__ __forceinline__ void xcd_barrier(const XcdBarrier& b) {
    asm volatile("s_waitcnt vmcnt(0)" ::: "memory");
    __syncthreads();
    if (threadIdx.x == 0) {
        unsigned* bar = b.bar;
        __builtin_amdgcn_s_waitcnt(0);
        unsigned nloc = b.st[0], nx = b.st[1];
        if (nloc == 0u) { xcd_barrier_complete(bar, b.x, nloc, nx); b.st[0] = nloc; b.st[1] = nx; }
        const unsigned old = xb_add(&bar[XB_XSUB(b.x)], 1u);
        const unsigned gen = old / nloc;
        if (old + 1u == (gen + 1u) * nloc) {
            __builtin_amdgcn_fence(__ATOMIC_RELEASE, "agent");
            asm volatile("s_waitcnt vmcnt(0)" ::: "memory");
            const unsigned og = xb_add(&bar[XB_TOP], 1u);
            const unsigned tg = og / nx;
            if (og + 1u == (tg + 1u) * nx) xb_add(&bar[XB_TOPGEN], 1u);
            else XB_SPIN(xb_ld(&bar[XB_TOPGEN]) == tg, bar);
            __builtin_amdgcn_fence(__ATOMIC_ACQUIRE, "agent");
            xb_add(&bar[XB_XGEN(b.x)], 1u);
            asm volatile("s_waitcnt vmcnt(0)" ::: "memory");
        } else {
            XB_SPIN(xb_ld(&bar[XB_XGEN(b.x)]) == gen, bar);
            __builtin_amdgcn_fence(__ATOMIC_ACQUIRE, "agent");
            asm volatile("s_waitcnt vmcnt(0)" ::: "memory");
        }
    }
    __syncthreads();
}

#ifndef PG8_HALF_UNITS
#define PG8_HALF_UNITS 0
#endif
#ifndef PG8_KLOOP8
#define PG8_KLOOP8 0
#endif
constexpr int BM = 256, BK = 64, HALF = 128, HTB = HALF * BK * 2, STAGE_BYTES = 8 * HTB, NXCD = 8;
__device__ __forceinline__ int lds_byte(int r, int c) { const int st = (r >> 4) * 2 + (c >> 5), rr = r & 15, cc = c & 31, ob = rr * 64 + cc * 2; return st * 1024 + (ob ^ (((ob >> 9) & 1) << 5)); }
__device__ __forceinline__ void stage_rc(int b, int& R, int& C) { const int st = b / 1024, sb = b % 1024, swz = sb ^ (((sb >> 9) & 1) << 5); R = (st >> 1) * 16 + swz / 64; C = (st & 1) * 32 + (swz % 64) / 2; }
__device__ __forceinline__ int perm32(int rho) { const int n = rho >> 4, i = rho & 15; return 8 * (i >> 2) + 4 * n + (i & 3); }
struct Unit { int pm, pn, e, half; };

#ifndef XCD_TAIL
#define XCD_TAIL 1
#endif
template <int WGM> __device__ __forceinline__ bool static_order(int nM, int nN, int G, int c, int i, int& pm, int& pn, int& half) {
    const int nwg = nM * nN, full = nwg / G, nrem = nwg - full * G;
    long L = (long)i * G + c; half = 0;
    if (i >= full) {
        if (i > full || nrem == 0) return false;
        if (PG8_HALF_UNITS && 2 * nrem <= G && (G & 15) == 0) { const int uu = (c >> 4) * 8 + (c & 7); if (uu >= nrem) return false; L = (long)full * G + uu; half = 1 + ((c >> 3) & 1); }
    }
    int wgid = (int)L;
    if (XCD_TAIL && nrem > 0 && (G % NXCD) == 0 && nrem % (G / NXCD) == 0) {
        const int per = G / NXCD, R = nrem / per, xcd = c % NXCD, slot = c / NXCD;
        if (i >= full && xcd >= R) return false;
        wgid = (xcd < R ? xcd * (full + 1) * per : R * (full + 1) * per + (xcd - R) * full * per) + i * per + slot;
    } else {
        if (i >= full && c >= nrem) return false;
        const int q = nwg / NXCD, r = nwg % NXCD, xcd = wgid % NXCD, off = wgid / NXCD; wgid = (xcd < r ? xcd * (q + 1) : r * (q + 1) + (xcd - r) * q) + off;
    }
    const int nig = WGM * nN, gid = wgid / nig, fm = gid * WGM, gsz = (nM - fm) < WGM ? (nM - fm) : WGM;
    pm = fm + ((wgid % nig) % gsz); pn = (wgid % nig) / gsz; return true;
}

__device__ __forceinline__ void mfma_f8_scaled(f32x4& acc, const v8i32& rows, const v8i32& cols, int unit_scales) {
    asm volatile("v_mfma_scale_f32_16x16x128_f8f6f4 %0, %1, %2, %0, %3, %3 op_sel_hi:[0,0,0]" : "+v"(acc) : "v"(rows), "v"(cols), "v"(unit_scales));
}
template <class Epi, class Sched, int VAR = 0, bool F8 = false>
__device__ __forceinline__ void gemm_phase(LAS unsigned char* lds, const int K, const Sched& S, const Epi& E) {
    const int tid = threadIdx.x, wid = __builtin_amdgcn_readfirstlane(tid >> 6), lane = tid & 63, wr = wid >> 2, wc = wid & 3, fr = lane & 15, fq = lane >> 4;
    const int nt = K / BK;
    int sR[2], sC[2]; unsigned voffB[2];
#pragma unroll
    for (int i = 0; i < 2; ++i) { int R, C; stage_rc(tid * 16 + i * 8192, R, C); sR[i] = R; sC[i] = C; const int Rb = (R & ~31) + perm32(R & 31); voffB[i] = (unsigned)(Rb * K + C) * 2u; }
    const size_t kstep = (size_t)(BK * 2);
    const size_t hstepB = (size_t)HALF * K * 2;
    const unsigned ldsw = (unsigned)wid * 1024u;
    const int aoff = lds_byte(wr * 64 + fr, fq * 8), boff = lds_byte(wc * 32 + fr, fq * 8);
#define PG8_SA(b, h) (((b) * 2 + (h)) * HTB)
#define PG8_SB(b, h) ((4 + (b) * 2 + (h)) * HTB)
#define PG8_STAGE(bufoff, gbase, voff) do { if constexpr (VAR != 3) _Pragma("unroll") for (int _i = 0; _i < 2; ++_i) \
        __builtin_amdgcn_global_load_lds((const unsigned*)((const char*)(gbase) + (voff)[_i]), (LAS unsigned*)(lds + (bufoff) + ldsw + _i * 8192), 16, 0, 0); } while (0)
#define PG8_LDA(dst, b, h) do { if constexpr (VAR != 2) _Pragma("unroll") for (int m = 0; m < 4; ++m) _Pragma("unroll") for (int k = 0; k < 2; ++k) dst[m][k] = *(const LAS bf16x8*)(lds + PG8_SA(b, h) + aoff + m * 2048 + k * 1024); } while (0)
#define PG8_LDB(dst, b, h) do { if constexpr (VAR != 2) _Pragma("unroll") for (int n = 0; n < 2; ++n) _Pragma("unroll") for (int k = 0; k < 2; ++k) dst[n][k] = *(const LAS bf16x8*)(lds + PG8_SB(b, h) + boff + n * 2048 + k * 1024); } while (0)
#define PG8_MMA(ai, bj, At, Bt) do { __builtin_amdgcn_s_setprio(1); if constexpr (VAR != 1) { if constexpr (F8) { \
        _Pragma("unroll") for (int m = 0; m < 4; ++m) _Pragma("unroll") for (int n = 0; n < 2; ++n) { \
            const i32x4 b0_ = __builtin_bit_cast(i32x4, Bt[n][0]), b1_ = __builtin_bit_cast(i32x4, Bt[n][1]), a0_ = __builtin_bit_cast(i32x4, At[m][0]), a1_ = __builtin_bit_cast(i32x4, At[m][1]); \
            const v8i32 bv_ = __builtin_shufflevector(b0_, b1_, 0, 1, 2, 3, 4, 5, 6, 7), av_ = __builtin_shufflevector(a0_, a1_, 0, 1, 2, 3, 4, 5, 6, 7); \
            mfma_f8_scaled(acc[ai][bj][m][n], bv_, av_, f8_scales); } \
        } else { _Pragma("unroll") for (int m = 0; m < 4; ++m) _Pragma("unroll") for (int n = 0; n < 2; ++n) _Pragma("unroll") for (int k = 0; k < 2; ++k) \
        acc[ai][bj][m][n] = __builtin_amdgcn_mfma_f32_16x16x32_bf16(Bt[n][k], At[m][k], acc[ai][bj][m][n], 0, 0, 0); } } __builtin_amdgcn_s_setprio(0); } while (0)
#ifndef ALIGN_MID
#define ALIGN_MID 1
#endif
#define PG8_WAIT_V(n) asm volatile("s_waitcnt vmcnt(" #n ")" ::: "memory")
#define PG8_WAIT_L(n) asm volatile("s_waitcnt lgkmcnt(" #n ")" ::: "memory")
#define PG8_BAR __builtin_amdgcn_s_barrier()
#define PG8_SCHED __builtin_amdgcn_sched_barrier(0)
#define PG8_KBODY(MMA_A0, MMA_A1, HALFB) \
            const bool last = (t == nt - 2); \
            if constexpr (Epi::HAS_MID) { if (t == nt / 2) { if (ALIGN_MID && wr == 0) PG8_BAR; E.template mid<HALFB>(acc, cur, wr, wc, fr, fq); if (ALIGN_MID && wr == 1) PG8_BAR; } } \
            const char* a1 = cA + (size_t)(t + 1) * kstep; \
            const char* a2 = last ? nA : cA + (size_t)(t + 2) * kstep; const char* b2 = last ? nB : cB + (size_t)(t + 2) * kstep; \
            const char* a3 = a2 + kstep; const char* b3 = b2 + kstep; \
            unsigned v20[2], v21[2]; \
_Pragma("unroll") \
            for (int i = 0; i < 2; ++i) { v20[i] = (Sched::GATHER && last) ? nV0[i] : cV0[i]; v21[i] = (Sched::GATHER && last) ? nV1[i] : cV1[i]; } \
            PG8_LDB(B0, 0, 0); PG8_LDB(B1, 0, 1); PG8_SCHED; PG8_LDA(At, 0, 0); PG8_STAGE(PG8_SA(1, 1), a1, cV1); \
            PG8_WAIT_V(8); PG8_WAIT_L(0); PG8_BAR; MMA_A0 PG8_BAR; PG8_SCHED; \
            PG8_LDA(At, 0, 1); PG8_STAGE(PG8_SB(0, 0), b2, voffB); PG8_STAGE(PG8_SB(0, 1), b2 + hstepB, voffB); PG8_STAGE(PG8_SA(0, 0), a2, v20); \
            PG8_WAIT_V(8); PG8_WAIT_L(0); PG8_BAR; MMA_A1 PG8_BAR; PG8_SCHED; \
            PG8_LDB(B0, 1, 0); PG8_LDB(B1, 1, 1); PG8_SCHED; PG8_LDA(At, 1, 0); PG8_STAGE(PG8_SA(0, 1), a2, v21); \
            PG8_WAIT_V(8); PG8_WAIT_L(0); PG8_BAR; MMA_A0 PG8_BAR; PG8_SCHED; \
            PG8_LDA(At, 1, 1); PG8_STAGE(PG8_SB(1, 0), b3, voffB); PG8_STAGE(PG8_SB(1, 1), b3 + hstepB, voffB); PG8_STAGE(PG8_SA(1, 0), a3, v20); \
            PG8_WAIT_V(8); PG8_WAIT_L(0); PG8_BAR; MMA_A1 PG8_BAR; PG8_SCHED;
#define PG8_KBODY8(HALFB) \
            const bool last = (t == nt - 2); \
            if constexpr (Epi::HAS_MID) { if (t == nt / 2) E.template mid<HALFB>(acc, cur, wr, wc, fr, fq); } \
            const char* a1 = cA + (size_t)(t + 1) * kstep; \
            const char* a2 = last ? nA : cA + (size_t)(t + 2) * kstep; const char* b2 = last ? nB : cB + (size_t)(t + 2) * kstep; \
            const char* a3 = a2 + kstep; const char* b3 = b2 + kstep; \
            unsigned v20[2], v21[2]; \
_Pragma("unroll") \
            for (int i = 0; i < 2; ++i) { v20[i] = (Sched::GATHER && last) ? nV0[i] : cV0[i]; v21[i] = (Sched::GATHER && last) ? nV1[i] : cV1[i]; } \
            PG8_LDB(B0, 0, 0); PG8_SCHED; PG8_LDA(At, 0, 0); PG8_STAGE(PG8_SA(1, 1), a1, cV1); \
            PG8_WAIT_L(8); PG8_BAR; PG8_WAIT_L(0); PG8_MMA(0, 0, At, B0); PG8_BAR; PG8_SCHED; \
            PG8_LDB(B1, 0, 1); PG8_STAGE(PG8_SB(0, 0), b2, voffB); \
            PG8_BAR; PG8_WAIT_L(0); PG8_MMA(0, 1, At, B1); PG8_BAR; \
            PG8_LDA(At, 0, 1); PG8_STAGE(PG8_SA(0, 0), a2, v20); \
            PG8_BAR; PG8_WAIT_L(0); PG8_MMA(1, 0, At, B0); PG8_BAR; PG8_SCHED; \
            PG8_STAGE(PG8_SB(0, 1), b2 + hstepB, voffB); \
            PG8_WAIT_V(6); PG8_BAR; PG8_MMA(1, 1, At, B1); PG8_BAR; \
            PG8_LDB(B0, 1, 0); PG8_SCHED; PG8_LDA(At, 1, 0); PG8_STAGE(PG8_SA(0, 1), a2, v21); \
            PG8_WAIT_L(8); PG8_BAR; PG8_WAIT_L(0); PG8_MMA(0, 0, At, B0); PG8_BAR; PG8_SCHED; \
            PG8_LDB(B1, 1, 1); PG8_STAGE(PG8_SB(1, 0), b3, voffB); \
            PG8_BAR; PG8_WAIT_L(0); PG8_MMA(0, 1, At, B1); PG8_BAR; \
            PG8_LDA(At, 1, 1); PG8_STAGE(PG8_SA(1, 0), a3, v20); \
            PG8_BAR; PG8_WAIT_L(0); PG8_MMA(1, 0, At, B0); PG8_BAR; PG8_SCHED; \
            PG8_STAGE(PG8_SB(1, 1), b3 + hstepB, voffB); \
            PG8_WAIT_V(6); PG8_BAR; PG8_MMA(1, 1, At, B1); PG8_BAR;
    const int f8_scales = 0x7F7F7F7F;
    Unit cur, nxt; int ui = 0;
    if (!S.next(0, cur)) return;
    f32x4 acc[2][2][4][2];
#pragma unroll
    for (int a = 0; a < 2; ++a)
#pragma unroll
        for (int b = 0; b < 2; ++b)
#pragma unroll
            for (int m = 0; m < 4; ++m)
#pragma unroll
                for (int n = 0; n < 2; ++n) acc[a][b][m][n] = (f32x4){0.f, 0.f, 0.f, 0.f};
    bf16x8 At[4][2] = {}, B0[2][2] = {}, B1[2][2] = {};
    unsigned cV0[2], cV1[2], nV0[2], nV1[2];
    S.a_voff(cur, cV0, cV1, sR, sC);
#pragma unroll
    for (int i = 0; i < 2; ++i) { nV0[i] = cV0[i]; nV1[i] = cV1[i]; }
    const char* cA = S.a_base(cur); const char* cB = S.b_base(cur);
#if PG8_KLOOP8
    PG8_STAGE(PG8_SB(0, 0), cB, voffB); PG8_STAGE(PG8_SA(0, 0), cA, cV0); PG8_STAGE(PG8_SB(0, 1), cB + hstepB, voffB); PG8_STAGE(PG8_SA(0, 1), cA, cV1);
    if (wr == 1) PG8_BAR;
    PG8_WAIT_V(4); PG8_BAR;
#else
    PG8_STAGE(PG8_SB(0, 0), cB, voffB); PG8_STAGE(PG8_SB(0, 1), cB + hstepB, voffB); PG8_STAGE(PG8_SA(0, 0), cA, cV0); PG8_STAGE(PG8_SA(0, 1), cA, cV1);
    if (wr == 1) PG8_BAR;
    PG8_WAIT_V(2); PG8_BAR;
#endif
    PG8_STAGE(PG8_SB(1, 0), cB + kstep, voffB); PG8_STAGE(PG8_SA(1, 0), cA + kstep, cV0); PG8_STAGE(PG8_SB(1, 1), cB + hstepB + kstep, voffB);
    PG8_WAIT_V(6); PG8_BAR;
    for (;;) {
        const bool has_next = S.next(ui + 1, nxt);
        const char* nA = has_next ? S.a_base(nxt) : cA; const char* nB = has_next ? S.b_base(nxt) : cB;
        if constexpr (Sched::GATHER) { if (has_next) S.a_voff(nxt, nV0, nV1, sR, sC); }
        if (ui > 0 && wr == 1) PG8_BAR;
#if PG8_KLOOP8
        if (true) {
            for (int t = 0; t < nt; t += 2) { PG8_KBODY8(false) }
        } else
#endif
        if (cur.half == 0) {
            for (int t = 0; t < nt; t += 2) { PG8_KBODY({ PG8_MMA(0, 0, At, B0); PG8_MMA(0, 1, At, B1); }, { PG8_MMA(1, 0, At, B0); PG8_MMA(1, 1, At, B1); }, false) }
        } else {
            const int hf = cur.half;
            for (int t = 0; t < nt; t += 2) { PG8_KBODY(if (hf != 2) { PG8_MMA(0, 0, At, B0); PG8_MMA(0, 1, At, B1); }, if (hf != 1) { PG8_MMA(1, 0, At, B0); PG8_MMA(1, 1, At, B1); }, true) }
        }
        if constexpr (F8) asm volatile("s_nop 15\n\ts_nop 7" ::: "memory");
        if (wr == 0) PG8_BAR;
        if (cur.half == 0) E.template run<false>(acc, cur, wr, wc, fr, fq); else E.template run<true>(acc, cur, wr, wc, fr, fq);
        if (!has_next) break;
#pragma unroll
        for (int a = 0; a < 2; ++a)
#pragma unroll
            for (int b = 0; b < 2; ++b)
#pragma unroll
                for (int m = 0; m < 4; ++m)
#pragma unroll
                    for (int n = 0; n < 2; ++n) acc[a][b][m][n] = (f32x4){0.f, 0.f, 0.f, 0.f};
        cur = nxt; cA = nA; cB = nB; ++ui;
        if constexpr (Sched::GATHER) {
#pragma unroll
            for (int i = 0; i < 2; ++i) { cV0[i] = nV0[i]; cV1[i] = nV1[i]; }
        }
    }
    PG8_WAIT_V(0);
    PG8_BAR;
#undef PG8_SA
#undef PG8_SB
#undef PG8_STAGE
#undef PG8_LDA
#undef PG8_LDB
#undef PG8_MMA
#undef PG8_WAIT_V
#undef PG8_WAIT_L
#undef PG8_BAR
#undef PG8_SCHED
#undef PG8_KBODY
#undef PG8_KBODY8
}

template <int WGM = 4> struct SchedPlainT {
    static constexpr bool GATHER = false;
    const char* A; const char* Bt; int K, nM, nN, G, c;
    __device__ __forceinline__ bool next(int i, Unit& u) const { u.e = 0; return static_order<WGM>(nM, nN, G, c, i, u.pm, u.pn, u.half); }
    __device__ __forceinline__ const char* a_base(const Unit& u) const { return A + (size_t)u.pm * BM * K * 2; }
    __device__ __forceinline__ const char* b_base(const Unit& u) const { return Bt + (size_t)u.pn * BM * K * 2; }
    __device__ __forceinline__ void a_voff(const Unit&, unsigned (&v0)[2], unsigned (&v1)[2], const int (&sR)[2], const int (&sC)[2]) const {
#pragma unroll
        for (int i = 0; i < 2; ++i) { v0[i] = (unsigned)(sR[i] * K + sC[i]) * 2u; v1[i] = (unsigned)((sR[i] + HALF) * K + sC[i]) * 2u; }
    }
};
typedef SchedPlainT<4> SchedPlain;
constexpr size_t WS_CTL   = 0;
constexpr int    CW_CNT   = 4096;
constexpr int    CW_DQ    = 4352;
constexpr size_t WS_SS1   = 65536;
constexpr size_t WS_SS2   = WS_SS1 + (size_t)T * 4;
constexpr size_t WS_ZERO_BYTES = WS_SS2 + (size_t)T * 4;
constexpr size_t WS_TE    = WS_ZERO_BYTES;
constexpr size_t WS_TP    = WS_TE + (size_t)NASSIGN * 4;
constexpr size_t WS_TW    = WS_TP + (size_t)NASSIGN * 4;
constexpr size_t WS_ROPE  = WS_TW + (size_t)NASSIGN * 4;
constexpr size_t WS_WRG   = WS_ROPE + (size_t)SEQ * 8 * 8;
constexpr size_t WS_LIST  = WS_WRG + (size_t)D * NE * 4;
constexpr size_t WS_WIN_T = WS_LIST + (size_t)NE * T * 4;
constexpr size_t WS_WOA_T = WS_WIN_T + (size_t)DIN * D * 2;
constexpr size_t WS_WOUT_T = WS_WOA_T + (size_t)D * D * 2;
constexpr size_t WS_WCQ_T = WS_WOUT_T + (size_t)D * D * 2;
constexpr size_t WS_WCKV_T = WS_WCQ_T + (size_t)512 * D * 2;
constexpr size_t WS_WCO_T = WS_WCKV_T + (size_t)1024 * D * 2;
constexpr size_t WS_WGU_T = WS_WCO_T + (size_t)D * 512 * 2;
constexpr size_t WS_WD_T  = WS_WGU_T + (size_t)NE * 4096 * D * 2;
constexpr size_t WS_XB    = WS_WD_T + (size_t)NE * D * D * 2;
constexpr size_t WS_MEMB  = WS_XB + (size_t)T * D * 2;
constexpr size_t WS_PROJB = WS_MEMB + (size_t)NMEM * D * 2;
constexpr size_t WS_GATES = WS_PROJB + (size_t)T * PROJW * 2;
constexpr size_t WS_Y     = WS_GATES + (size_t)T * GATEW * 2;
constexpr size_t WS_YMOE  = WS_PROJB;
constexpr size_t WS_MERGED = WS_Y + (size_t)T * D * 2;
constexpr size_t WS_X1    = WS_MERGED + (size_t)T * D * 2;
constexpr size_t WS_QC    = WS_X1 + (size_t)T * D * 4;
constexpr size_t WS_KVC   = WS_QC + (size_t)T * 512 * 2;
constexpr size_t WS_OC    = WS_KVC + (size_t)NMEM * 1024 * 2;
constexpr size_t WS_ACT   = WS_OC + (size_t)T * 512 * 2;
constexpr size_t WS_END   = WS_ACT + (size_t)MAXTILES * 256 * D * 2;
static_assert(WS_Y + (size_t)T * D * 2 - WS_PROJB >= (size_t)MAXTILES * 256 * D * 2, "YMOE overlay fits");
static_assert(WS_END <= (size_t)2147483648u, "workspace fits in 2 GiB");
static_assert(WS_TE % 256 == 0 && WS_WIN_T % 256 == 0 && WS_XB % 256 == 0 && WS_X1 % 256 == 0 && WS_ACT % 256 == 0, "alignment");

struct Args {
    const float* in[24]; float* out; unsigned char* ws; int ph_lo, ph_hi;
};

#ifndef F8_GU
#define F8_GU 1
#endif
#ifndef F8_P1
#define F8_P1 1
#endif
#ifndef F8_P3
#define F8_P3 1
#endif
#ifndef F8_P4
#define F8_P4 1
#endif
#ifndef F8_Y
#define F8_Y 1
#endif
#ifndef F8_DN
#define F8_DN 1
#endif
struct P0Item { const float* W; const float* g; bf16_t* WT; int N, ldk, kofs, drow0, k0, n0, q8; };
__device__ __forceinline__ void p0_load(const P0Item& t, f32x4 (&v)[16], int lane) {
    const int lr = lane >> 4, lc = 4 * (lane & 15);
#pragma unroll
    for (int i = 0; i < 16; ++i) {
        const char* base = (const char*)(t.W + (size_t)(t.k0 + 4 * i) * t.N + t.n0);
        v[i] = __builtin_nontemporal_load((const f32x4*)(base + (size_t)(unsigned)((lr * t.N + lc) * 4)));
    }
}
__device__ __forceinline__ void p0_finish(const P0Item& t, f32x4 (&v)[16], LAS float* scr, int lane) {
    const int lr = lane >> 4, lc = 4 * (lane & 15);
    if (t.g) {
#pragma unroll
        for (int i = 0; i < 16; ++i) { const float gs = t.g[t.k0 + lr + 4 * i]; v[i] = v[i] * gs; }
    }
#pragma unroll
    for (int i = 0; i < 16; ++i) { LAS float* s = scr + (lr + 4 * i) * 65 + lc; s[0] = v[i][0]; s[1] = v[i][1]; s[2] = v[i][2]; s[3] = v[i][3]; }
    LDS_WAIT(); asm volatile("" ::: "memory");
    if (t.q8) {
        const int c4 = lane & 3;
#pragma unroll
        for (int j = 0; j < 4; ++j) { const int n = (lane >> 2) + 16 * j; const LAS float* s = scr + (16 * c4) * 65 + n;
            u32x4 o;
            o.x = pk4_fp8(s[0 * 65] * 64.f, s[1 * 65] * 64.f, s[2 * 65] * 64.f, s[3 * 65] * 64.f);     o.y = pk4_fp8(s[4 * 65] * 64.f, s[5 * 65] * 64.f, s[6 * 65] * 64.f, s[7 * 65] * 64.f);
            o.z = pk4_fp8(s[8 * 65] * 64.f, s[9 * 65] * 64.f, s[10 * 65] * 64.f, s[11 * 65] * 64.f);   o.w = pk4_fp8(s[12 * 65] * 64.f, s[13 * 65] * 64.f, s[14 * 65] * 64.f, s[15 * 65] * 64.f);
            __builtin_nontemporal_store(o, (u32x4*)((unsigned char*)t.WT + (size_t)(t.drow0 + n) * t.ldk + t.kofs + t.k0 + 16 * c4)); }
        LDS_WAIT(); asm volatile("" ::: "memory");
        return;
    }
    const int c = lane & 7;
#pragma unroll
    for (int j = 0; j < 8; ++j) { const int n = (lane >> 3) + 8 * j; const LAS float* s = scr + (8 * c) * 65 + n;
        u32x4 o; o.x = cvt_pk_bf16(s[0 * 65], s[1 * 65]); o.y = cvt_pk_bf16(s[2 * 65], s[3 * 65]); o.z = cvt_pk_bf16(s[4 * 65], s[5 * 65]); o.w = cvt_pk_bf16(s[6 * 65], s[7 * 65]);
        __builtin_nontemporal_store(o, (u32x4*)(t.WT + (size_t)(t.drow0 + n) * t.ldk + t.kofs + t.k0 + 8 * c)); }
    LDS_WAIT(); asm volatile("" ::: "memory");
}
__device__ __forceinline__ void rms_row_to_bf16(const float* __restrict__ xrow, bf16_t* __restrict__ orow, int lane) {
    const f32x4* xr = (const f32x4*)xrow + lane;
    f32x4 v[8]; float s = 0.f;
#pragma unroll
    for (int j = 0; j < 8; ++j) { v[j] = xr[64 * j]; s += (v[j][0] * v[j][0] + v[j][1] * v[j][1]) + (v[j][2] * v[j][2] + v[j][3] * v[j][3]); }
    const float rstd = 1.0f / sqrtf(wave_sum(s) * (1.0f / D) + EPS);
    u32x2* o8 = (u32x2*)orow + lane;
#pragma unroll
    for (int j = 0; j < 8; ++j) { u32x2 o; o.x = pk2(v[j][0] * rstd, v[j][1] * rstd); o.y = pk2(v[j][2] * rstd, v[j][3] * rstd); o8[64 * j] = o; }
}
constexpr int SCRW = 128 * 33 * 4;
__device__ __forceinline__ void p0_load_w(const P0Item& t, f32x4 (&v)[16], int lane) {
    const int lr = lane >> 3, lc = 4 * (lane & 7);
#pragma unroll
    for (int i = 0; i < 16; ++i) {
        const char* base = (const char*)(t.W + (size_t)(t.k0 + 8 * i) * t.N + t.n0);
        v[i] = __builtin_nontemporal_load((const f32x4*)(base + (size_t)(unsigned)((lr * t.N + lc) * 4)));
    }
}
template<int GAIN> __device__ __forceinline__ void p0_finish_w(const P0Item& t, f32x4 (&v)[16], LAS float* scr, const LAS float* gl, int lane) {
    const int lr = lane >> 3, lc = 4 * (lane & 7);
#pragma unroll
    for (int i = 0; i < 16; ++i) { LAS float* s = scr + (lr + 8 * i) * 33 + lc; s[0] = v[i][0]; s[1] = v[i][1]; s[2] = v[i][2]; s[3] = v[i][3]; }
    LDS_WAIT(); asm volatile("" ::: "memory");
    const int c8 = lane & 7;
    f32x4 g0 = {64.f, 64.f, 64.f, 64.f}, g1 = g0, g2 = g0, g3 = g0;
    if (GAIN == 1) { const LAS f32x4* gp = (const LAS f32x4*)(gl + t.k0 + 16 * c8); g0 = gp[0]; g1 = gp[1]; g2 = gp[2]; g3 = gp[3]; }
    if (GAIN == 2) { const f32x4* gp = (const f32x4*)(t.g + t.k0 + 16 * c8); g0 = gp[0] * 64.f; g1 = gp[1] * 64.f; g2 = gp[2] * 64.f; g3 = gp[3] * 64.f; }
#pragma unroll
    for (int j = 0; j < 4; ++j) { const int n = (lane >> 3) + 8 * j; const LAS float* s = scr + (16 * c8) * 33 + n;
        u32x4 o;
        o.x = pk4_fp8(s[0 * 33] * g0[0], s[1 * 33] * g0[1], s[2 * 33] * g0[2], s[3 * 33] * g0[3]);     o.y = pk4_fp8(s[4 * 33] * g1[0], s[5 * 33] * g1[1], s[6 * 33] * g1[2], s[7 * 33] * g1[3]);
        o.z = pk4_fp8(s[8 * 33] * g2[0], s[9 * 33] * g2[1], s[10 * 33] * g2[2], s[11 * 33] * g2[3]);   o.w = pk4_fp8(s[12 * 33] * g3[0], s[13 * 33] * g3[1], s[14 * 33] * g3[2], s[15 * 33] * g3[3]);
        unsigned char* base = (unsigned char*)t.WT + (size_t)(t.drow0 + 8 * j) * t.ldk + t.kofs + t.k0;
        __builtin_nontemporal_store(o, (u32x4*)(base + (size_t)(unsigned)((lane >> 3) * t.ldk + 16 * c8))); }
    LDS_WAIT(); asm volatile("" ::: "memory");
}
#ifndef MAP_CONTIG
#define MAP_CONTIG 0
#endif
#ifndef GU_DB
#define GU_DB 1
#endif
#ifndef DEFER_N3
#define DEFER_N3 10
#endif
#ifndef DEFER_N4
#define DEFER_N4 10
#endif
#ifndef DEFER_N7
#define DEFER_N7 10
#endif
constexpr int P0_I_IN = 32 * 136, P0_I_NA = 16 * 32, P0_I_WIN = 16 * 32, P0_I_OUT = 32 * 32, P0_I_CQ = 32 * 8, P0_I_CKV = 32 * 16, P0_I_CO = 8 * 32, P0_I_E = 32 * 32;
constexpr int P0_I_SMALL = P0_I_IN + P0_I_NA + P0_I_WIN + P0_I_OUT + P0_I_CQ + P0_I_CKV + P0_I_CO;
constexpr int GU_TILES = 2 * NE * P0_I_E, GU_P0_TILES = GU_TILES - 2048 * (DEFER_N3 + DEFER_N4 + DEFER_N7);
static_assert(GU_P0_TILES >= 0 && GU_P0_TILES % 1024 == 0, "deferred tiles: the prologue (64k x 64n tiles) and the hosts (128k x 32n tiles) split the gate/up matrices at matrix granularity");
__device__ __forceinline__ void p0_decode(const Args& a, int it, P0Item& t) {
    unsigned char* ws = a.ws;
    const float* W; const float* g = nullptr; bf16_t* WT; int N, ldk, kofs = 0, nblk, r = it; bool gu = false, up = false;
    bool q8in = false;
    if (r < P0_I_IN) { W = a.in[3]; N = DIN; g = a.in[2]; WT = (bf16_t*)(ws + WS_WIN_T); ldk = D; nblk = 136; q8in = F8_P1 != 0; }
    else if ((r -= P0_I_IN) < P0_I_NA) { W = a.in[6]; N = D; WT = (bf16_t*)(ws + WS_WOA_T); ldk = D; nblk = 32; q8in = F8_P3 != 0; }
    else if ((r -= P0_I_NA) < P0_I_WIN) { W = a.in[7]; N = D; WT = (bf16_t*)(ws + WS_WOA_T); ldk = D; kofs = 1024; nblk = 32; q8in = F8_P3 != 0; }
    else if ((r -= P0_I_WIN) < P0_I_OUT) { W = a.in[8]; N = D; WT = (bf16_t*)(ws + WS_WOUT_T); ldk = D; nblk = 32; q8in = F8_P4 != 0; }
    else if ((r -= P0_I_OUT) < P0_I_CQ) { W = a.in[11]; N = 512; g = a.in[9]; WT = (bf16_t*)(ws + WS_WCQ_T); ldk = D; nblk = 8; }
    else if ((r -= P0_I_CQ) < P0_I_CKV) { W = a.in[12]; N = 1024; g = a.in[10]; WT = (bf16_t*)(ws + WS_WCKV_T); ldk = D; nblk = 16; }
    else if ((r -= P0_I_CKV) < P0_I_CO) { W = a.in[13]; N = D; WT = (bf16_t*)(ws + WS_WCO_T); ldk = 512; nblk = 32; }
    else { r -= P0_I_CO; const int mtx = r / P0_I_E; r -= mtx * P0_I_E; const int e = mtx >> 1, which = mtx & 1; N = D; nblk = 32; ldk = D;
        W = a.in[which == 0 ? 17 : 19] + (size_t)e * D * D; g = a.in[14]; gu = true; up = (which == 1);
        WT = F8_GU ? (bf16_t*)(ws + WS_WGU_T + (size_t)e * 4096 * D) : (bf16_t*)(ws + WS_WGU_T) + (size_t)e * 4096 * D; }
    const int q8 = ((gu && F8_GU) || q8in) ? 1 : 0;
    if (q8) nblk *= 2;
    const int kb = r / nblk, nb = r - kb * nblk, k0 = (q8 ? 128 : 64) * kb, n0 = (q8 ? 32 : 64) * nb;
    t.W = W; t.g = g; t.WT = WT; t.N = N; t.ldk = ldk; t.kofs = kofs; t.k0 = k0; t.n0 = n0; t.q8 = q8;
    t.drow0 = gu ? 256 * (n0 >> 7) + (n0 & 127) + (up ? 128 : 0) : n0;
}
__device__ __forceinline__ void rms_row_to_fp8(const float* __restrict__ xrow, unsigned char* __restrict__ orow, int lane) {
    const f32x4* xr = (const f32x4*)xrow + lane;
    f32x4 v[8]; float s = 0.f;
#pragma unroll
    for (int j = 0; j < 8; ++j) { v[j] = xr[64 * j]; s += (v[j][0] * v[j][0] + v[j][1] * v[j][1]) + (v[j][2] * v[j][2] + v[j][3] * v[j][3]); }
    const float rstd = 1.0f / sqrtf(wave_sum(s) * (1.0f / D) + EPS);
    unsigned* o4 = (unsigned*)orow + lane;
#pragma unroll
    for (int j = 0; j < 8; ++j) o4[64 * j] = pk4_fp8(v[j][0] * rstd, v[j][1] * rstd, v[j][2] * rstd, v[j][3] * rstd);
}
__device__ __forceinline__ void p0_prologue(const Args& a, LAS unsigned char* lds, int vcu, int G) {
    const int lane = threadIdx.x & 63, wave = __builtin_amdgcn_readfirstlane(threadIdx.x >> 6);
    LAS float* scr = (LAS float*)(lds + wave * SCRW);
    const int gw = vcu * NWAVES + wave, NGW = G * NWAVES;
    unsigned char* ws = a.ws;
    constexpr int NITEMS = P0_I_SMALL + GU_P0_TILES;
    auto decode = [&](int it, P0Item& t) { p0_decode(a, it, t); };
    {
        f32x4 va[16], vb[16]; P0Item ta, tb; int it = gw;
        auto load = [&](const P0Item& t, f32x4 (&v)[16]) { if (t.q8) p0_load_w(t, v, lane); else p0_load(t, v, lane); };
        auto finish = [&](const P0Item& t, f32x4 (&v)[16]) { if (t.q8) { if (t.g) p0_finish_w<2>(t, v, scr, nullptr, lane); else p0_finish_w<0>(t, v, scr, nullptr, lane); } else p0_finish(t, v, scr, lane); };
        if (it < NITEMS) { decode(it, ta); load(ta, va); }
        while (it < NITEMS) {
            const int it1 = it + NGW, it2 = it + 2 * NGW;
            if (it1 < NITEMS) { decode(it1, tb); load(tb, vb); }
            finish(ta, va);
            if (it1 >= NITEMS) break;
            if (it2 < NITEMS) { decode(it2, ta); load(ta, va); }
            finish(tb, vb);
            it = it2;
        }
    }
    if (F8_P1) { for (int m = gw; m < T; m += NGW) rms_row_to_fp8(a.in[0] + (size_t)m * D, (unsigned char*)(ws + WS_XB) + (size_t)m * D, lane); }
    else { for (int m = gw; m < T; m += NGW) rms_row_to_bf16(a.in[0] + (size_t)m * D, (bf16_t*)(ws + WS_XB) + (size_t)m * D, lane); }
    for (int m = gw; m < NMEM; m += NGW) rms_row_to_bf16(a.in[1] + (size_t)m * D, (bf16_t*)(ws + WS_MEMB) + (size_t)m * D, lane);
    const int gt = vcu * NTHREADS + threadIdx.x, NGT = G * NTHREADS;
    for (int i = gt; i < D * NE; i += NGT) ((float*)(ws + WS_WRG))[i] = a.in[14][i >> 5] * a.in[15][i];
    for (int i = gt; i < SEQ * 8; i += NGT) {
        const int pos = i >> 3, k = i & 7; const float inv = exp2f(-(float)k * 0.125f * 18.931568569324174f); const float ang = (float)pos * inv;
        const double rev = (double)ang * 0.15915494309189535; const float fr = (float)(rev - floor(rev));
        ((float2*)(ws + WS_ROPE))[i] = make_float2(__builtin_amdgcn_cosf(fr), __builtin_amdgcn_sinf(fr));
    }
}

#ifndef TR_CONV
#define TR_CONV 1
#endif
__device__ __forceinline__ s16x4 ds_tr16_p0(const LAS unsigned char* p) {
    typedef short v4i16_t __attribute__((ext_vector_type(4)));
    return __builtin_bit_cast(s16x4, __builtin_amdgcn_ds_read_tr16_b64_v4i16((LAS v4i16_t*)p));
}
template<int GAIN> __device__ __forceinline__ void p0_finish_tr(const P0Item& t, f32x4 (&v)[16], LAS float* scr, const LAS float* gl, int lane) {
    LAS unsigned char* img = (LAS unsigned char*)scr;
    const int lr = lane >> 3, l7 = lane & 7;
#pragma unroll
    for (int i = 0; i < 16; ++i) { u32x2 w; w.x = cvt_pk_bf16(v[i][0], v[i][1]); w.y = cvt_pk_bf16(v[i][2], v[i][3]); *(LAS u32x2*)(img + (lr + 8 * i) * 64 + 8 * l7) = w; }
    LDS_WAIT(); asm volatile("" ::: "memory");
    const int l = lane & 15, gq = lane >> 4; const bool lo8 = l < 8;
#pragma unroll
    for (int nh = 0; nh < 2; ++nh) {
        u32x4 o[2];
#pragma unroll
        for (int h = 0; h < 2; ++h) {
            const int c = 4 * h + gq;
            f32x4 g[4] = {{64.f, 64.f, 64.f, 64.f}, {64.f, 64.f, 64.f, 64.f}, {64.f, 64.f, 64.f, 64.f}, {64.f, 64.f, 64.f, 64.f}};
            if (GAIN == 1) { const LAS f32x4* gp = (const LAS f32x4*)(gl + t.k0 + 16 * c); g[0] = gp[0]; g[1] = gp[1]; g[2] = gp[2]; g[3] = gp[3]; }
#pragma unroll
            for (int s4 = 0; s4 < 4; ++s4) {
                const s16x4 q = ds_tr16_p0(img + (16 * c + 4 * s4 + (l >> 2)) * 64 + 8 * (l & 3) + 32 * nh);
                const float f0 = __uint_as_float((unsigned)(unsigned short)q[0] << 16), f1 = __uint_as_float((unsigned)(unsigned short)q[1] << 16), f2 = __uint_as_float((unsigned)(unsigned short)q[2] << 16), f3 = __uint_as_float((unsigned)(unsigned short)q[3] << 16);
                o[h][s4] = pk4_fp8(f0 * g[s4][0], f1 * g[s4][1], f2 * g[s4][2], f3 * g[s4][3]);
            }
        }
        u32x4 y;
#pragma unroll
        for (int e = 0; e < 4; ++e) { const unsigned x = lo8 ? o[1][e] : o[0][e]; y[e] = (unsigned)__builtin_amdgcn_update_dpp(0, (int)x, 0x128, 0xf, 0xf, false); }
        const u32x4 s1 = lo8 ? o[0] : y, s2 = lo8 ? y : o[1];
        const int c1 = lo8 ? gq : 4 + gq;
        unsigned char* base = (unsigned char*)t.WT + (size_t)(t.drow0 + 16 * nh) * t.ldk + t.kofs + t.k0;
        __builtin_nontemporal_store(s1, (u32x4*)(base + (size_t)(unsigned)((l & 7) * t.ldk + 16 * c1)));
        __builtin_nontemporal_store(s2, (u32x4*)(base + (size_t)(unsigned)((8 + (l & 7)) * t.ldk + 16 * c1)));
        asm volatile("" ::: "memory");
    }
    LDS_WAIT(); asm volatile("" ::: "memory");
}
template<int GAIN> __device__ __forceinline__ void PFIN(const P0Item& t, f32x4 (&v)[16], LAS float* scr, const LAS float* gl, int lane) { if constexpr (TR_CONV && GAIN != 2) p0_finish_tr<GAIN>(t, v, scr, gl, lane); else p0_finish_w<GAIN>(t, v, scr, gl, lane); }
template<int CNT, int GAIN, class Dec> __device__ __forceinline__ void convert_run(LAS float* scr, const LAS float* gl, int lane, Dec dec) {
    if (CNT <= 0) return;
    f32x4 va[16], vb[16]; P0Item ta, tb;
    dec(0, ta); p0_load_w(ta, va, lane);
    int n = 0;
#pragma unroll 1
    for (; n + 2 < CNT; n += 2) {
        dec(n + 1, tb); p0_load_w(tb, vb, lane);
        PFIN<GAIN>(ta, va, scr, gl, lane);
        dec(n + 2, ta); p0_load_w(ta, va, lane);
        PFIN<GAIN>(tb, vb, scr, gl, lane);
    }
    if (CNT % 2 == 0) { dec(CNT - 1, tb); p0_load_w(tb, vb, lane); PFIN<GAIN>(ta, va, scr, gl, lane); PFIN<GAIN>(tb, vb, scr, gl, lane); }
    else PFIN<GAIN>(ta, va, scr, gl, lane);
}
static_assert(F8_DN && F8_GU, "the hosted conversion writes fp8 tiles");
__device__ __forceinline__ void down_item(const Args& a, int it, P0Item& t) {
    const int e = it >> 10, r = it & 1023, kb = r >> 6, nb = r & 63;
    t.W = a.in[21] + (size_t)e * D * D; t.g = nullptr; t.WT = (bf16_t*)(a.ws + WS_WD_T + (size_t)e * D * D); t.N = D; t.ldk = D; t.kofs = 0; t.k0 = 128 * kb; t.n0 = 32 * nb; t.drow0 = 32 * nb; t.q8 = 1;
}
template<int CNT> __device__ __forceinline__ void convert_down_static(const Args& a, LAS unsigned char* lds, int first, int widx_, int stride) {
    const int lane = threadIdx.x & 63, wave = __builtin_amdgcn_readfirstlane(threadIdx.x >> 6);
    const int widx = __builtin_amdgcn_readfirstlane(widx_);
    LAS float* scr = (LAS float*)(lds + wave * SCRW);
    convert_run<CNT, 0>(scr, nullptr, lane, [&](int n, P0Item& t) { down_item(a, MAP_CONTIG ? first + widx * CNT + n : first + widx + stride * n, t); });
}
__device__ __forceinline__ void convert_down_drain(const Args& a, LAS unsigned char* lds, int first) {
    const int lane = threadIdx.x & 63, wave = __builtin_amdgcn_readfirstlane(threadIdx.x >> 6);
    LAS float* scr = (LAS float*)(lds + wave * SCRW);
    unsigned* dq = (unsigned*)(a.ws + WS_CTL) + CW_DQ;
    constexpr int NT = NE * 32 * 32;
    for (;;) {
        unsigned c = 0; if (lane == 0) c = __hip_atomic_fetch_add(dq, 1u, __ATOMIC_RELAXED, __HIP_MEMORY_SCOPE_AGENT);
        const int base = first + 4 * (int)__builtin_amdgcn_readfirstlane(c);
        if (base >= NT) break;
        convert_run<4, 0>(scr, nullptr, lane, [&](int n, P0Item& t) { down_item(a, base + n, t); });
    }
}
__device__ __forceinline__ void gu_item(const Args& a, int r, P0Item& t) {
    const int mtx = r >> 10, rr = r & 1023, e = mtx >> 1, which = mtx & 1, kb = rr >> 6, nb = rr & 63, n0 = 32 * nb;
    t.W = a.in[which == 0 ? 17 : 19] + (size_t)e * D * D; t.g = nullptr; t.N = D; t.ldk = D; t.kofs = 0; t.k0 = 128 * kb; t.n0 = n0; t.q8 = F8_GU;
    t.WT = F8_GU ? (bf16_t*)(a.ws + WS_WGU_T + (size_t)e * 4096 * D) : (bf16_t*)(a.ws + WS_WGU_T) + (size_t)e * 4096 * D;
    t.drow0 = 256 * (n0 >> 7) + (n0 & 127) + (which ? 128 : 0);
}
template<int CNT> __device__ __forceinline__ void convert_gu_chunk(const Args& a, LAS unsigned char* lds, int first) {
    const int lane = threadIdx.x & 63, wave = __builtin_amdgcn_readfirstlane(threadIdx.x >> 6);
    LAS float* scr = (LAS float*)(lds + wave * SCRW);
    LAS float* gl = (LAS float*)(lds + NWAVES * SCRW);
    for (int i = threadIdx.x; i < D; i += NTHREADS) gl[i] = a.in[14][i] * (F8_GU ? 64.f : 1.f);
    __syncthreads();
    const int widx = blockIdx.x * NWAVES + wave;
    if (CNT > 0 && widx < 2048) convert_run<CNT, 1>(scr, gl, lane, [&](int n, P0Item& t) { gu_item(a, first + widx + 2048 * n, t); });
}
__device__ __forceinline__ float sigmoidf_(float x) { return __builtin_amdgcn_rcpf(1.0f + __expf(-x)); }
__device__ __forceinline__ int opaque(int x) { asm volatile("" : "+v"(x)); return x; }

#ifndef WIDE_ST
#define WIDE_ST 1
#endif
__device__ __forceinline__ u32x4 widen_rows(u32x2 a, u32x2 b) {
    const auto r0 = __builtin_amdgcn_permlane16_swap(a.x, b.x, false, false);
    const auto r1 = __builtin_amdgcn_permlane16_swap(a.y, b.y, false, false);
    return (u32x4){(unsigned)r0[0], (unsigned)r1[0], (unsigned)r0[1], (unsigned)r1[1]};
}
#ifndef G8
#define G8 1
#endif
__device__ __forceinline__ unsigned gate_q8(float g) { const float q = __builtin_fminf(__builtin_fmaxf(g * 255.0f + 0.5f, 1.0f), 255.0f); return (unsigned)q; }
__device__ __forceinline__ unsigned gate_pk4(float a, float b, float c, float d) { return gate_q8(a) | (gate_q8(b) << 8) | (gate_q8(c) << 16) | (gate_q8(d) << 24); }
__device__ __forceinline__ float gate_b(unsigned w, int i) { return (float)((w >> (8 * i)) & 0xffu); }
struct EpiProj {
    static constexpr bool HAS_MID = false;
    bf16_t* projb; bf16_t* gates; const float* rope;
    template <bool HU> __device__ __forceinline__ void run(const f32x4 (&acc)[2][2][4][2], const Unit& u, int wr, int wc, int fr, int fq) const {
        const int pn = u.pn, row0 = opaque(u.pm * BM + wr * 64 + fr), colw = wc * 32 + 8 * fq;
        if (pn < 18) {
            const float scale = ((pn < 4 || (pn >= 12 && pn < 16)) ? 0.125f * 1.4426950408889634f : 1.0f) * (F8_P1 ? 0.015625f : 1.0f);
            const bool rope_wave = (pn >= 12 && pn < 17) && ((wc & 1) == 0);
#pragma unroll
            for (int ai = 0; ai < 2; ++ai) if (!HU || u.half != 2 - ai)
#pragma unroll
                for (int m = 0; m < 4; ++m) {
                    const int row = row0 + ai * HALF + m * 16;
                    bf16_t* rowp = projb + (size_t)row * PROJW + pn * BM + colw;
                    f32x4 c0 = {1.f, 1.f, 1.f, 1.f}, c1 = c0, s0 = {0.f, 0.f, 0.f, 0.f}, s1 = s0;
                    if (rope_wave) {
                        const f32x4* rp = (const f32x4*)(rope + (size_t)(row & (SEQ - 1)) * 16);
                        const f32x4 r0 = rp[0], r1 = rp[1], r2 = rp[2], r3 = rp[3];
                        const float sg = (fq == 0) ? -1.f : 1.f; const bool on = fq < 2;
                        c0 = on ? (f32x4){r0[0], r0[2], r1[0], r1[2]} : c0; c1 = on ? (f32x4){r2[0], r2[2], r3[0], r3[2]} : c1;
                        s0 = on ? (f32x4){r0[1], r0[3], r1[1], r1[3]} * sg : s0; s1 = on ? (f32x4){r2[1], r2[3], r3[1], r3[3]} * sg : s1;
                    }
#pragma unroll
                    for (int bj = 0; bj < 2; ++bj) {
                        f32x4 v0 = acc[ai][bj][m][0] * scale, v1 = acc[ai][bj][m][1] * scale;
                        if (rope_wave) {
                            f32x4 p0, p1;
#pragma unroll
                            for (int j = 0; j < 4; ++j) { p0[j] = __shfl_xor(v0[j], 16); p1[j] = __shfl_xor(v1[j], 16); }
                            v0 = v0 * c0 + p0 * s0; v1 = v1 * c1 + p1 * s1;
                        }
                        u32x4 w; w.x = cvt_pk_bf16(v0[0], v0[1]); w.y = cvt_pk_bf16(v0[2], v0[3]); w.z = cvt_pk_bf16(v1[0], v1[1]); w.w = cvt_pk_bf16(v1[2], v1[3]);
                        *(u32x4*)(rowp + bj * HALF) = w;
                    }
                }
        } else {
            if constexpr (G8 && WIDE_ST && !HU) {
                const int odd = fq & 1; const float sc1 = F8_P1 ? 0.015625f : 1.0f;
#pragma unroll
                for (int ai = 0; ai < 2; ++ai)
#pragma unroll
                    for (int mp = 0; mp < 4; mp += 2)
#pragma unroll
                        for (int bj = 0; bj < 2; ++bj) {
                            u32x2 w8[2];
#pragma unroll
                            for (int q = 0; q < 2; ++q) { const f32x4 v0 = acc[ai][bj][mp + q][0] * sc1, v1 = acc[ai][bj][mp + q][1] * sc1;
                                w8[q].x = gate_pk4(sigmoidf_(v0[0]), sigmoidf_(v0[1]), sigmoidf_(v0[2]), sigmoidf_(v0[3])); w8[q].y = gate_pk4(sigmoidf_(v1[0]), sigmoidf_(v1[1]), sigmoidf_(v1[2]), sigmoidf_(v1[3])); }
                            *(u32x4*)((unsigned char*)gates + (size_t)(row0 + ai * HALF + (mp + odd) * 16) * GATEW + (pn - 18) * BM + colw - 8 * odd + bj * HALF) = widen_rows(w8[0], w8[1]);
                        }
                return;
            }
#pragma unroll
            for (int ai = 0; ai < 2; ++ai) if (!HU || u.half != 2 - ai)
#pragma unroll
                for (int m = 0; m < 4; ++m) {
                    bf16_t* rowp = gates + (size_t)(row0 + ai * HALF + m * 16) * GATEW + (pn - 18) * BM + colw;
                    unsigned char* rowp8 = (unsigned char*)gates + (size_t)(row0 + ai * HALF + m * 16) * GATEW + (pn - 18) * BM + colw;
#pragma unroll
                    for (int bj = 0; bj < 2; ++bj) {
                        const f32x4 v0 = acc[ai][bj][m][0] * (F8_P1 ? 0.015625f : 1.0f), v1 = acc[ai][bj][m][1] * (F8_P1 ? 0.015625f : 1.0f);
                        if (G8) { u32x2 w8; w8.x = gate_pk4(sigmoidf_(v0[0]), sigmoidf_(v0[1]), sigmoidf_(v0[2]), sigmoidf_(v0[3])); w8.y = gate_pk4(sigmoidf_(v1[0]), sigmoidf_(v1[1]), sigmoidf_(v1[2]), sigmoidf_(v1[3]));
                            *(u32x2*)(rowp8 + bj * HALF) = w8; }
                        else { u32x4 w; w.x = cvt_pk_bf16(sigmoidf_(v0[0]), sigmoidf_(v0[1])); w.y = cvt_pk_bf16(sigmoidf_(v0[2]), sigmoidf_(v0[3]));
                        w.z = cvt_pk_bf16(sigmoidf_(v1[0]), sigmoidf_(v1[1])); w.w = cvt_pk_bf16(sigmoidf_(v1[2]), sigmoidf_(v1[3]));
                        *(u32x4*)(rowp + bj * HALF) = w; }
                    }
                }
        }
    }
};

struct EpiMerge {
    static constexpr bool HAS_MID = true;
    const bf16_t* gates; bf16_t* merged;
    template <bool HU> __device__ __forceinline__ void mid(f32x4 (&acc)[2][2][4][2], const Unit& u, int wr, int wc, int fr, int fq) const {
        const int row0 = opaque(u.pm * BM + wr * 64 + fr), col0 = u.pn * BM + wc * 32 + 8 * fq;
#pragma unroll
        for (int ai = 0; ai < 2; ++ai) if (!HU || u.half != 2 - ai) {
            if constexpr (G8) {
                u32x2 ga[4][2], gb[4][2];
#pragma unroll
                for (int m = 0; m < 4; ++m) { const unsigned char* gp = (const unsigned char*)gates + (size_t)(row0 + ai * HALF + m * 16) * GATEW + col0;
#pragma unroll
                    for (int bj = 0; bj < 2; ++bj) { ga[m][bj] = *(const u32x2*)(gp + bj * HALF); gb[m][bj] = *(const u32x2*)(gp + 2048 + bj * HALF); } }
#pragma unroll
                for (int m = 0; m < 4; ++m)
#pragma unroll
                    for (int bj = 0; bj < 2; ++bj)
#pragma unroll
                        for (int i = 0; i < 8; ++i) acc[ai][bj][m][i >> 2][i & 3] *= gate_b(ga[m][bj][i >> 2], i & 3) * __builtin_amdgcn_rcpf(gate_b(gb[m][bj][i >> 2], i & 3));
                asm volatile("" ::: "memory");
                continue;
            }
            u32x4 ga[4][2], gb[4][2];
#pragma unroll
            for (int m = 0; m < 4; ++m) { const bf16_t* gp = gates + (size_t)(row0 + ai * HALF + m * 16) * GATEW + col0;
#pragma unroll
                for (int bj = 0; bj < 2; ++bj) { ga[m][bj] = *(const u32x4*)(gp + bj * HALF); gb[m][bj] = *(const u32x4*)(gp + 2048 + bj * HALF); } }
#pragma unroll
            for (int m = 0; m < 4; ++m)
#pragma unroll
                for (int bj = 0; bj < 2; ++bj)
#pragma unroll
                    for (int e = 0; e < 4; ++e) {
                        const float a0 = __uint_as_float(ga[m][bj][e] << 16), a1 = __uint_as_float(ga[m][bj][e] & 0xffff0000u), b0 = __uint_as_float(gb[m][bj][e] << 16), b1 = __uint_as_float(gb[m][bj][e] & 0xffff0000u);
                        acc[ai][bj][m][e >> 1][(e & 1) * 2 + 0] *= a0 * __builtin_amdgcn_rcpf(b0);
                        acc[ai][bj][m][e >> 1][(e & 1) * 2 + 1] *= a1 * __builtin_amdgcn_rcpf(b1);
                    }
            asm volatile("" ::: "memory");
        }
    }
    template <bool HU> __device__ __forceinline__ void run(const f32x4 (&acc)[2][2][4][2], const Unit& u, int wr, int wc, int fr, int fq) const {
        const int row0 = opaque(u.pm * BM + wr * 64 + fr), col0 = u.pn * BM + wc * 32 + 8 * fq;
        const float osc = F8_P3 ? 1.0f / 1024.0f : 1.0f;
        u32x4 gb[2][4][2];
#pragma unroll
        for (int ai = 0; ai < 2; ++ai) if (!HU || u.half != 2 - ai)
#pragma unroll
            for (int m = 0; m < 4; ++m)
#pragma unroll
                for (int bj = 0; bj < 2; ++bj) {
                    if (G8) { const u32x2 g8 = *(const u32x2*)((const unsigned char*)gates + (size_t)(row0 + ai * HALF + m * 16) * GATEW + 2048 + col0 + bj * HALF); gb[ai][m][bj] = (u32x4){g8.x, g8.y, 0u, 0u}; }
                    else gb[ai][m][bj] = *(const u32x4*)(gates + (size_t)(row0 + ai * HALF + m * 16) * GATEW + 2048 + col0 + bj * HALF);
                }
        if constexpr (F8_P4 && G8 && WIDE_ST && !HU) {
            const int odd = fq & 1; const float gs = osc * (8.0f / 255.0f);
#pragma unroll
            for (int ai = 0; ai < 2; ++ai)
#pragma unroll
                for (int mp = 0; mp < 4; mp += 2)
#pragma unroll
                    for (int bj = 0; bj < 2; ++bj) {
                        u32x2 w8[2];
#pragma unroll
                        for (int q = 0; q < 2; ++q) { float v[8];
#pragma unroll
                            for (int i = 0; i < 8; ++i) v[i] = acc[ai][bj][mp + q][i >> 2][i & 3] * gs * gate_b(gb[ai][mp + q][bj][i >> 2], i & 3);
                            w8[q].x = pk4_fp8(v[0], v[1], v[2], v[3]); w8[q].y = pk4_fp8(v[4], v[5], v[6], v[7]); }
                        *(u32x4*)((unsigned char*)merged + (size_t)(row0 + ai * HALF + (mp + odd) * 16) * D + col0 - 8 * odd + bj * HALF) = widen_rows(w8[0], w8[1]);
                    }
            return;
        }
#pragma unroll
        for (int ai = 0; ai < 2; ++ai) if (!HU || u.half != 2 - ai)
#pragma unroll
            for (int m = 0; m < 4; ++m) {
                bf16_t* op = merged + (size_t)(row0 + ai * HALF + m * 16) * D + col0;
#pragma unroll
                for (int bj = 0; bj < 2; ++bj) {
                    float v[8];
#pragma unroll
                    for (int e = 0; e < 4; ++e) {
                        if (G8) { v[2 * e] = acc[ai][bj][m][e >> 1][(e & 1) * 2] * (osc * (1.0f / 255.0f)) * gate_b(gb[ai][m][bj][(2 * e) >> 2], (2 * e) & 3);
                            v[2 * e + 1] = acc[ai][bj][m][e >> 1][(e & 1) * 2 + 1] * (osc * (1.0f / 255.0f)) * gate_b(gb[ai][m][bj][(2 * e + 1) >> 2], (2 * e + 1) & 3); }
                        else {
                        v[2 * e] = acc[ai][bj][m][e >> 1][(e & 1) * 2] * osc * __uint_as_float(gb[ai][m][bj][e] << 16);
                        v[2 * e + 1] = acc[ai][bj][m][e >> 1][(e & 1) * 2 + 1] * osc * __uint_as_float(gb[ai][m][bj][e] & 0xffff0000u); }
                    }
                    if (F8_P4) { u32x2 w8; w8.x = pk4_fp8(v[0] * 8.f, v[1] * 8.f, v[2] * 8.f, v[3] * 8.f); w8.y = pk4_fp8(v[4] * 8.f, v[5] * 8.f, v[6] * 8.f, v[7] * 8.f);
                        *(u32x2*)((unsigned char*)merged + (size_t)(row0 + ai * HALF + m * 16) * D + col0 + bj * HALF) = w8; }
                    else { u32x4 w; w.x = cvt_pk_bf16(v[0], v[1]); w.y = cvt_pk_bf16(v[2], v[3]); w.z = cvt_pk_bf16(v[4], v[5]); w.w = cvt_pk_bf16(v[6], v[7]);
                        *(u32x4*)(op + bj * HALF) = w; }
                }
            }
    }
};

template <bool WB> struct EpiResid {
    static constexpr bool HAS_MID = false;
    const float* xi; float* xo; bf16_t* xob; float* ss; float sc;
    template <bool HU> __device__ __forceinline__ void run(const f32x4 (&acc)[2][2][4][2], const Unit& u, int wr, int wc, int fr, int fq) const {
        const int row0 = opaque(u.pm * BM + wr * 64 + fr), col0 = u.pn * BM + wc * 32 + 8 * fq;
#pragma unroll
        for (int ai = 0; ai < 2; ++ai) if (!HU || u.half != 2 - ai) {
            f32x4 r[4][2][2];
#pragma unroll
            for (int m = 0; m < 4; ++m)
#pragma unroll
                for (int bj = 0; bj < 2; ++bj) { const float* p = xi + (size_t)(row0 + ai * HALF + m * 16) * D + col0 + bj * HALF; r[m][bj][0] = *(const f32x4*)p; r[m][bj][1] = *(const f32x4*)(p + 4); }
#pragma unroll
            for (int m = 0; m < 4; ++m) {
                const int row = row0 + ai * HALF + m * 16; const size_t off = (size_t)row * D + col0;
                float q = 0.f;
#pragma unroll
                for (int bj = 0; bj < 2; ++bj) {
                    const f32x4 v0 = r[m][bj][0] + acc[ai][bj][m][0] * sc, v1 = r[m][bj][1] + acc[ai][bj][m][1] * sc;
                    *(f32x4*)(xo + off + bj * HALF) = v0; *(f32x4*)(xo + off + bj * HALF + 4) = v1;
                    if constexpr (WB) { u32x4 w; w.x = cvt_pk_bf16(v0[0], v0[1]); w.y = cvt_pk_bf16(v0[2], v0[3]); w.z = cvt_pk_bf16(v1[0], v1[1]); w.w = cvt_pk_bf16(v1[2], v1[3]);
                        *(u32x4*)(xob + off + bj * HALF) = w; }
                    q += (v0[0] * v0[0] + v0[1] * v0[1]) + (v0[2] * v0[2] + v0[3] * v0[3]) + (v1[0] * v1[0] + v1[1] * v1[1]) + (v1[2] * v1[2] + v1[3] * v1[3]);
                }
                q += __shfl_xor(q, 16); q += __shfl_xor(q, 32);
                if (fq == 0) atomicAdd(ss + row, q);
            }
        }
    }
};

struct SchedCross {
    static constexpr bool GATHER = false;
    const char* A0; const char* B0; const char* A1; const char* B1; int K, G, c;
    __device__ __forceinline__ bool next(int i, Unit& u) const {
        const int L = i * G + c;
        u.half = 0;
        if (L < 128) { u.e = 0; u.pm = L >> 1; u.pn = L & 1; return true; }
        if (L < 144) { u.e = 1; u.pm = (L - 128) >> 2; u.pn = (L - 128) & 3; return true; }
        return false;
    }
    __device__ __forceinline__ const char* a_base(const Unit& u) const { return (u.e ? A1 : A0) + (size_t)u.pm * BM * K * 2; }
    __device__ __forceinline__ const char* b_base(const Unit& u) const { return (u.e ? B1 : B0) + (size_t)u.pn * BM * K * 2; }
    __device__ __forceinline__ void a_voff(const Unit&, unsigned (&v0)[2], unsigned (&v1)[2], const int (&sR)[2], const int (&sC)[2]) const {
#pragma unroll
        for (int i = 0; i < 2; ++i) { v0[i] = (unsigned)(sR[i] * K + sC[i]) * 2u; v1[i] = (unsigned)((sR[i] + HALF) * K + sC[i]) * 2u; }
    }
};
struct EpiCross {
    static constexpr bool HAS_MID = false;
    const float* ss1; bf16_t* qc; bf16_t* kvc;
    template <bool HU> __device__ __forceinline__ void run(const f32x4 (&acc)[2][2][4][2], const Unit& u, int wr, int wc, int fr, int fq) const {
        const int row0 = opaque(u.pm * BM + wr * 64 + fr), col0 = u.pn * BM + wc * 32 + 8 * fq;
        bf16_t* base = u.e ? kvc : qc; const int ldc = u.e ? 1024 : 512;
        float ssv[2][4];
#pragma unroll
        for (int ai = 0; ai < 2; ++ai) if (!HU || u.half != 2 - ai)
#pragma unroll
            for (int m = 0; m < 4; ++m) ssv[ai][m] = ss1[row0 + ai * HALF + m * 16];
#pragma unroll
        for (int ai = 0; ai < 2; ++ai) if (!HU || u.half != 2 - ai)
#pragma unroll
            for (int m = 0; m < 4; ++m) {
                const int row = row0 + ai * HALF + m * 16;
                const float sc = u.e ? 1.0f : (0.08838834764831845f * 1.4426950408889634f) / sqrtf(ssv[ai][m] * (1.0f / D) + EPS);
                bf16_t* op = base + (size_t)row * ldc + col0;
#pragma unroll
                for (int bj = 0; bj < 2; ++bj) {
                    const f32x4 v0 = acc[ai][bj][m][0] * sc, v1 = acc[ai][bj][m][1] * sc;
                    u32x4 w; w.x = cvt_pk_bf16(v0[0], v0[1]); w.y = cvt_pk_bf16(v0[2], v0[3]); w.z = cvt_pk_bf16(v1[0], v1[1]); w.w = cvt_pk_bf16(v1[2], v1[3]);
                    *(u32x4*)(op + bj * HALF) = w;
                }
            }
    }
};
__device__ __forceinline__ s16x4 ds_tr16(const LAS unsigned char* p) {
    typedef short v4i16_t __attribute__((ext_vector_type(4)));
    return __builtin_bit_cast(s16x4, __builtin_amdgcn_ds_read_tr16_b64_v4i16((LAS v4i16_t*)p));
}
template <int DH> __device__ __forceinline__ int vswz(int key, int q) {
    if (DH == 64) return q ^ (2 * (((key >> 1) & 1) | (((key >> 3) & 1) << 1)));
    return q ^ (2 * ((key & 1) | (((key >> 1) & 1) << 1) | (((key >> 3) & 1) << 2)));
}
template <int DH> __device__ __forceinline__ int kswz(int key, int q) {
#if defined(KSWZ_SIMPLE)
    return q ^ (key & (DH / 8 - 1));
#else
    if (DH == 64) return q ^ (((key >> 1) & 1) | (((key >> 3) & 3) << 1));
    return q ^ ((key & 3) | (((key >> 3) & 3) << 2));
#endif
}
template <int DH> __device__ __forceinline__ void load_q(bf16x8 (&qf)[DH / 32], const bf16_t* __restrict__ Q, int q_pitch, int q_row0, int lane) {
#pragma unroll
    for (int ks = 0; ks < DH / 32; ++ks) qf[ks] = *(const bf16x8*)(Q + (size_t)(q_row0 + (lane & 15)) * q_pitch + ks * 32 + 8 * (lane >> 4));
}
template <int DH, int NCH, bool HAS_SINK, int NRW, bool O8 = false, class KeyF, class MaskF>
__device__ __forceinline__ void attn_core(const bf16_t* __restrict__ Q, int q_pitch, int q_row0, const LAS unsigned char* kimg, const LAS unsigned char* vimg,
                                          const KeyF& keyf, const MaskF& mb, float sink, bf16_t* __restrict__ O, int o_pitch, int lane, const bf16x8 (&qf)[DH / 32]) {
    constexpr int NKS = DH / 32, NDB = DH / 16, ROWB = DH * 2;
    const int qi = lane & 15, g = lane >> 4;
    f32x4 s[NCH][2];
#pragma unroll
    for (int c = 0; c < NCH; ++c)
#pragma unroll
        for (int tt = 0; tt < 2; ++tt) {
            int key = keyf(c) + 8 * (qi >> 2) + 4 * tt + (qi & 3); if (NRW && key >= NRW) key -= NRW;
            const LAS unsigned char* kr = kimg + key * ROWB;
            f32x4 a = {0.f, 0.f, 0.f, 0.f};
#pragma unroll
            for (int ks = 0; ks < NKS; ++ks) a = __builtin_amdgcn_mfma_f32_16x16x32_bf16(*(const LAS bf16x8*)(kr + 16 * kswz<DH>(key, 4 * ks + g)), qf[ks], a, 0, 0, 0);
            s[c][tt] = a;
            if (tt == 1 && (c & 1)) __builtin_amdgcn_sched_barrier(0);
        }
    float mx = -INFINITY;
#pragma unroll
    for (int c = 0; c < NCH; ++c)
#pragma unroll
        for (int tt = 0; tt < 2; ++tt)
#pragma unroll
            for (int r = 0; r < 4; ++r) { const float v = s[c][tt][r] + mb(c, 8 * g + 4 * tt + r, qi); s[c][tt][r] = v; mx = fmaxf(mx, v); }
    mx = fmaxf(mx, __shfl_xor(mx, 16)); mx = fmaxf(mx, __shfl_xor(mx, 32));
    if (HAS_SINK) mx = fmaxf(mx, sink);
    float sum = 0.f;
    bf16x8 pf[NCH];
#pragma unroll
    for (int c = 0; c < NCH; ++c) {
        float e[8];
#pragma unroll
        for (int tt = 0; tt < 2; ++tt)
#pragma unroll
            for (int r = 0; r < 4; ++r) { const float p = __builtin_amdgcn_exp2f(s[c][tt][r] - mx); e[tt * 4 + r] = p; sum += p; }
        u32x4 w; w.x = cvt_pk_bf16(e[0], e[1]); w.y = cvt_pk_bf16(e[2], e[3]); w.z = cvt_pk_bf16(e[4], e[5]); w.w = cvt_pk_bf16(e[6], e[7]);
        pf[c] = __builtin_bit_cast(bf16x8, w);
    }
    sum += __shfl_xor(sum, 16); sum += __shfl_xor(sum, 32);
    if (HAS_SINK) sum += __builtin_amdgcn_exp2f(sink - mx);
    const float inv = 1.0f / sum;
    f32x4 o[NDB];
#pragma unroll
    for (int db = 0; db < NDB; ++db) o[db] = (f32x4){0.f, 0.f, 0.f, 0.f};
    const int cc = lane & 15;
#pragma unroll
    for (int c = 0; c < NCH; ++c) {
        int k0 = keyf(c) + 8 * g + (cc >> 2), k1 = k0 + 4; if (NRW && k0 >= NRW) k0 -= NRW; if (NRW && k1 >= NRW) k1 -= NRW;
        const LAS unsigned char* r0 = vimg + k0 * ROWB + 8 * (cc & 1); const LAS unsigned char* r1 = vimg + k1 * ROWB + 8 * (cc & 1);
#pragma unroll
        for (int db = 0; db < NDB; ++db) {
            const int q = 2 * db + ((cc & 3) >> 1);
            const s16x4 lo = ds_tr16(r0 + 16 * vswz<DH>(k0, q)), hi = ds_tr16(r1 + 16 * vswz<DH>(k1, q));
            const bf16x8 vf = {lo[0], lo[1], lo[2], lo[3], hi[0], hi[1], hi[2], hi[3]};
            o[db] = __builtin_amdgcn_mfma_f32_16x16x32_bf16(vf, pf[c], o[db], 0, 0, 0);
        }
        if (c & 1) __builtin_amdgcn_sched_barrier(0);
    }
    if constexpr (O8) {
        unsigned char* orow8 = (unsigned char*)O + (size_t)(q_row0 + qi) * o_pitch + 4 * g; const float i16 = inv * 16.f;
#pragma unroll
        for (int db = 0; db < NDB; ++db) *(unsigned*)(orow8 + 16 * db) = pk4_fp8(o[db][0] * i16, o[db][1] * i16, o[db][2] * i16, o[db][3] * i16);
    } else {
    bf16_t* orow = O + (size_t)(q_row0 + qi) * o_pitch + 4 * g;
#pragma unroll
    for (int db = 0; db < NDB; ++db) { u32x2 w; w.x = cvt_pk_bf16(o[db][0] * inv, o[db][1] * inv); w.y = cvt_pk_bf16(o[db][2] * inv, o[db][3] * inv); *(u32x2*)(orow + 16 * db) = w; }
    }
}

template <int DH, int NROWS> struct Stager {
    static constexpr int CPR = DH / 8, PPI = NROWS * CPR, NP = (2 * PPI + NTHREADS - 1) / NTHREADS, ROWB = DH * 2, IMGB = NROWS * ROWB;
    u32x4 r[NP];
    template <class RowF> __device__ __forceinline__ void load(const bf16_t* __restrict__ Kp, const bf16_t* __restrict__ Vp, int pitch, const RowF& rowf) {
#pragma unroll
        for (int i = 0; i < NP; ++i) { const int p = threadIdx.x + NTHREADS * i; const bool isv = p >= PPI; const int pp = isv ? p - PPI : p, row = pp / CPR, q = pp % CPR;
            if (p < 2 * PPI) r[i] = *(const u32x4*)((isv ? Vp : Kp) + (size_t)rowf(row) * pitch + 8 * q); }
    }
    template <class SlotF> __device__ __forceinline__ void store_slots(LAS unsigned char* kimg, LAS unsigned char* vimg, const SlotF& slotf) const {
#pragma unroll
        for (int i = 0; i < NP; ++i) { const int p = threadIdx.x + NTHREADS * i; const bool isv = p >= PPI; const int pp = isv ? p - PPI : p, row = slotf(pp / CPR), q = pp % CPR;
            if (p < 2 * PPI) *(LAS u32x4*)((isv ? vimg : kimg) + row * ROWB + 16 * (isv ? vswz<DH>(row, q) : kswz<DH>(row, q))) = r[i]; }
    }
    __device__ __forceinline__ void store(LAS unsigned char* kimg, LAS unsigned char* vimg) const {
#pragma unroll
        for (int i = 0; i < NP; ++i) { const int p = threadIdx.x + NTHREADS * i; const bool isv = p >= PPI; const int pp = isv ? p - PPI : p, row = pp / CPR, q = pp % CPR;
            if (p < 2 * PPI) *(LAS u32x4*)((isv ? vimg : kimg) + row * ROWB + 16 * (isv ? vswz<DH>(row, q) : kswz<DH>(row, q))) = r[i]; }
    }
};

__device__ __forceinline__ void p2_attention(const Args& a, LAS unsigned char* lds, int vcu, int G) {
    const int tid = threadIdx.x, lane = tid & 63, wave = __builtin_amdgcn_readfirstlane(tid >> 6);
    unsigned char* ws = a.ws;
    const bf16_t* PROJB = (const bf16_t*)(ws + WS_PROJB); bf16_t* Y = (bf16_t*)(ws + WS_Y);
    constexpr int NUNITS = 2048, UPW_MIN = 8;
    const int upw = ((NUNITS + G - 1) / G + UPW_MIN - 1) / UPW_MIN * UPW_MIN;
    const int u_lo = vcu * upw, u_hi = min(u_lo + upw, NUNITS);
    {
        LAS unsigned char* kimg = lds; LAS unsigned char* vimg = lds + 576 * 128; LAS float* rpl = (LAS float*)(lds + 2 * 576 * 128);
        const int j = wave >> 2, qg = wave & 3, c0 = 16 * qg, w0 = (qg == 0) ? 0 : (qg == 1) ? 8 : (qg == 2) ? 24 : 32;
        u32x4 inc[4];
        int have_hi = -1;
        for (int id = u_lo; id < u_hi; ++id) {
            const int rp = id & 31, h = (id >> 5) & 15, b = id >> 9;
            const int rs0 = min(max(2 * rp - 4, 0), 56);
            const bf16_t* Kg = PROJB + 1024 + h * 64; const bf16_t* Vg = PROJB + 2048 + h * 64;
            const bool fresh = (have_hi < 0) || rp == 0;
            __syncthreads();
            if (fresh) {
                Stager<64, 576> st;
                auto rf = [&](int row) { return b * SEQ + min(rs0 + (row >> 6), 63) * 64 + (row & 63); };
                st.load(Kg, Vg, PROJW, rf);
                auto sf = [&](int row) { return ((rs0 + (row >> 6)) % 9) * 64 + (row & 63); };
                st.store_slots(kimg, vimg, sf);
                if (tid < 465) rpl[tid] = a.in[4][h * 465 + tid] * 1.4426950408889634f;
            } else {
                const int d = rs0 + 9 - have_hi;
#pragma unroll
                for (int i = 0; i < 4; ++i) { const int p = tid + NTHREADS * i; const int isv = p >> 10, rr = (p >> 9) & 1, col = (p >> 3) & 63, q = p & 7;
                    if (rr < d) { const int srow = ((have_hi + rr) % 9) * 64 + col; *(LAS u32x4*)((isv ? vimg : kimg) + srow * 128 + 16 * (isv ? vswz<64>(srow, q) : kswz<64>(srow, q))) = inc[i]; } }
            }
            have_hi = rs0 + 9;
            __syncthreads();
            const int r = 2 * rp + j, rs = min(max(r - 4, 0), 56);
            bf16x8 qf[2]; load_q<64>(qf, PROJB + h * 64, PROJW, b * SEQ + r * 64 + c0, lane);
            __builtin_amdgcn_sched_barrier(0);
            if (id + 1 < u_hi && ((id + 1) & 31) != 0) {
                const int rs0n = min(max(2 * (rp + 1) - 4, 0), 56), dn = rs0n + 9 - have_hi;
#pragma unroll
                for (int i = 0; i < 4; ++i) { const int p = tid + NTHREADS * i; const int isv = p >> 10, rr = (p >> 9) & 1, col = (p >> 3) & 63, q = p & 7;
                    if (rr < dn) inc[i] = *(const u32x4*)((isv ? Vg : Kg) + (size_t)(b * SEQ + min(have_hi + rr, 63) * 64 + col) * PROJW + 8 * q); }
            }
            __builtin_amdgcn_sched_barrier(0);
            const int qc = c0 + (lane & 15), csq = min(max(qc - 8, 0), 48);
            const LAS float* rp_ = rpl + (rs - r + 7) * 31;
            const int m0 = rs % 9;
            auto keyf = [&](int c) { const int m = m0 + c; return (m >= 9 ? m - 9 : m) * 64 + w0; };
            const int relb = w0 - csq, dcb = w0 - qc + 15;
            auto mb = [&](int c, int key, int) { const float bias = rp_[dcb + (c * 31 + key)]; return ((unsigned)(relb + key) < 16u) ? bias : -INFINITY; };
            attn_core<64, 8, false, 0, F8_P3 != 0>(PROJB + h * 64, PROJW, b * SEQ + r * 64 + c0, kimg, vimg, keyf, mb, 0.f, F8_P3 ? (bf16_t*)((unsigned char*)Y + h * 64) : Y + h * 64, D, lane, qf);
        }
    }
    __syncthreads();
    {
        LAS unsigned char* kimg = lds; LAS unsigned char* vimg = lds + 320 * 128;
        const int jq = wave >> 2, grp = wave & 3;
        const int isv = tid >> 8, nr = (tid & 255) >> 3, nq = tid & 7;
        u32x4 inc;
        bool have = false;
        for (int id = u_lo; id < u_hi; ++id) {
            const int qb = id & 127, hkv = (id >> 7) & 3, b = id >> 9;
            const bf16_t* Kg = PROJB + 4096 + hkv * 64; const bf16_t* Vg = PROJB + 4352 + hkv * 64;
            const bool fresh = !have || qb == 0;
            __syncthreads();
            if (fresh) {
                Stager<64, 320> st;
                auto rf = [&](int row) { return b * SEQ + min(max(32 * qb - 128 + row, 0), SEQ - 1); };
                st.load(Kg, Vg, PROJW, rf);
                auto sf = [&](int row) { return (32 * qb - 128 + row + 1280) % 320; };
                st.store_slots(kimg, vimg, sf);
            } else {
                const int srow = (32 * qb + 160 + nr + 1280) % 320;
                *(LAS u32x4*)((isv ? vimg : kimg) + srow * 128 + 16 * (isv ? vswz<64>(srow, nq) : kswz<64>(srow, nq))) = inc;
            }
            have = true;
            __syncthreads();
            const int hq = hkv * 4 + grp;
            const int qp0 = 32 * qb + 16 * jq, kp0 = qp0 - 128, qp = qp0 + (lane & 15);
            bf16x8 qf[2]; load_q<64>(qf, PROJB + 3072 + hq * 64, PROJW, b * SEQ + qp0, lane);
            __builtin_amdgcn_sched_barrier(0);
            if (id + 1 < u_hi && ((id + 1) & 127) != 0)
                inc = *(const u32x4*)((isv ? Vg : Kg) + (size_t)(b * SEQ + min(32 * (qb + 1) + 160 + nr, SEQ - 1)) * PROJW + 8 * nq);
            __builtin_amdgcn_sched_barrier(0);
            const int s0 = (kp0 + 1280) % 320;
            auto keyf = [&](int c) { const int m = s0 + 32 * c; return m >= 320 ? m - 320 : m; };
            const int qi_ = lane & 15;
            auto mb = [&](int c, int key, int) { const bool inb = (unsigned)(kp0 + (32 * c + key)) < (unsigned)SEQ; const bool win = (c == 0) ? (key >= qi_) : (c == 8) ? (key <= qi_) : true;
                                                 return (inb && win) ? 0.f : -INFINITY; };
            attn_core<64, 9, true, 320, F8_P3 != 0>(PROJB + 3072 + hq * 64, PROJW, b * SEQ + qp0, kimg, vimg, keyf, mb, a.in[5][hq] * 1.4426950408889634f, F8_P3 ? (bf16_t*)((unsigned char*)Y + 1024 + hq * 64) : Y + 1024 + hq * 64, D, lane, qf);
        }
    }
}

__device__ __forceinline__ void p6_cross_attention(const Args& a, LAS unsigned char* lds, int vcu, int G) {
    const int lane = threadIdx.x & 63, wave = __builtin_amdgcn_readfirstlane(threadIdx.x >> 6);
    unsigned char* ws = a.ws;
    const bf16_t* QC = (const bf16_t*)(ws + WS_QC); const bf16_t* KVC = (const bf16_t*)(ws + WS_KVC); bf16_t* OC = (bf16_t*)(ws + WS_OC);
    constexpr int NR = 256;
    LAS unsigned char* kimg = lds; LAS unsigned char* vimg = lds + NR * 256;
    for (int pr = vcu; pr < BATCH * 4 * 16; pr += G) {
        const int qpair = pr & 15, h = (pr >> 4) & 3, b = pr >> 6;
        auto rf = [&](int row) { return b * MEM + row; };
        Stager<128, NR> st;
        st.load(KVC + h * 128, KVC + 512 + h * 128, 1024, rf);
        __syncthreads();
        st.store(kimg, vimg);
        __syncthreads();
        auto keyf = [&](int c) { return 32 * c; };
        auto mb = [&](int, int, int) { return 0.f; };
#pragma unroll 1
        for (int u = 0; u < 2; ++u) {
            bf16x8 qf[4]; load_q<128>(qf, QC + h * 128, 512, b * SEQ + (qpair * 2 + u) * 128 + wave * 16, lane);
            attn_core<128, 8, false, 0>(QC + h * 128, 512, b * SEQ + (qpair * 2 + u) * 128 + wave * 16, kimg, vimg, keyf, mb, 0.f, OC + h * 128, 512, lane, qf);
        }
    }
}
__device__ __forceinline__ void p8_router(const Args& a, LAS unsigned char* lds, int vcu, int G) {
    const int tid = threadIdx.x, lane = tid & 63, wave = __builtin_amdgcn_readfirstlane(tid >> 6);
    unsigned char* ws = a.ws;
    const float* X2 = (const float*)(ws + WS_X1); const float* WRG = (const float*)(ws + WS_WRG); const float* SS2 = (const float*)(ws + WS_SS2);
    int* cnt = (int*)(ws + WS_CTL) + CW_CNT; int* TE = (int*)(ws + WS_TE); int* TP = (int*)(ws + WS_TP); float* TW = (float*)(ws + WS_TW); int* LIST = (int*)(ws + WS_LIST);
    LAS float* part = (LAS float*)lds;
    const int tg = wave & 1, kq = wave >> 1;
    for (int blk = vcu; blk < T / 64; blk += G) {
        const int tok0 = blk * 64 + tg * 32;
        f32x16 acc;
#pragma unroll
        for (int i = 0; i < 16; ++i) acc[i] = 0.f;
        const float* xr = X2 + (size_t)(tok0 + (lane & 31)) * D + kq * 512 + 4 * (lane >> 5);
        const float* wr = WRG + (size_t)(kq * 512 + 4 * (lane >> 5)) * NE + (lane & 31);
#pragma unroll 4
        for (int k0 = 0; k0 < 512; k0 += 8) {
            const f32x4 xa = *(const f32x4*)(xr + k0);
            const float b0 = wr[(size_t)(k0 + 0) * NE], b1 = wr[(size_t)(k0 + 1) * NE], b2 = wr[(size_t)(k0 + 2) * NE], b3 = wr[(size_t)(k0 + 3) * NE];
            acc = __builtin_amdgcn_mfma_f32_32x32x2f32(xa[0], b0, acc, 0, 0, 0);
            acc = __builtin_amdgcn_mfma_f32_32x32x2f32(xa[1], b1, acc, 0, 0, 0);
            acc = __builtin_amdgcn_mfma_f32_32x32x2f32(xa[2], b2, acc, 0, 0, 0);
            acc = __builtin_amdgcn_mfma_f32_32x32x2f32(xa[3], b3, acc, 0, 0, 0);
        }
#pragma unroll
        for (int r = 0; r < 16; ++r) part[(wave * 32 + (r & 3) + 8 * (r >> 2) + 4 * (lane >> 5)) * 33 + (lane & 31)] = acc[r];
        __syncthreads();
        if (tid < 64) {
            const int tl = tid & 31, g2 = tid >> 5, tok = blk * 64 + tid;
            const float rstd = 1.0f / sqrtf(SS2[tok] * (1.0f / D) + EPS);
            float v0 = -INFINITY, v1 = -INFINITY, v2 = -INFINITY, v3 = -INFINITY; int i0 = 0, i1 = 0, i2 = 0, i3 = 0;
#pragma unroll
            for (int e = 0; e < NE; ++e) {
                float l = 0.f;
#pragma unroll
                for (int q = 0; q < 4; ++q) l += part[((q * 2 + g2) * 32 + tl) * 33 + e];
                l = l * rstd + a.in[16][e];
                if (l > v3) {
                    if (l > v2) { v3 = v2; i3 = i2; if (l > v1) { v2 = v1; i2 = i1; if (l > v0) { v1 = v0; i1 = i0; v0 = l; i0 = e; } else { v1 = l; i1 = e; } } else { v2 = l; i2 = e; } }
                    else { v3 = l; i3 = e; }
                }
            }
            const float w0 = 1.0f, w1 = expf(v1 - v0), w2 = expf(v2 - v0), w3 = expf(v3 - v0), inv = 1.0f / (w0 + w1 + w2 + w3);
            const int p0 = atomicAdd(cnt + i0, 1), p1 = atomicAdd(cnt + i1, 1), p2 = atomicAdd(cnt + i2, 1), p3 = atomicAdd(cnt + i3, 1);
            LIST[(size_t)i0 * T + p0] = tok; LIST[(size_t)i1 * T + p1] = tok; LIST[(size_t)i2 * T + p2] = tok; LIST[(size_t)i3 * T + p3] = tok;
            *(int4*)(TE + tok * 4) = make_int4(i0, i1, i2, i3); *(int4*)(TP + tok * 4) = make_int4(p0, p1, p2, p3);
            *(float4*)(TW + tok * 4) = make_float4(w0 * inv, w1 * inv, w2 * inv, w3 * inv);
        }
        __syncthreads();
    }
    {
        bf16_t* X2B = (bf16_t*)(ws + WS_XB);
        const int gw = vcu * NWAVES + wave, NGW = G * NWAVES;
        for (int m = gw; m < T; m += NGW) {
            const float rstd = 1.0f / sqrtf(SS2[m] * (1.0f / D) + EPS);
            const f32x4* xr = (const f32x4*)(X2 + (size_t)m * D) + lane;
            f32x4 v[8];
#pragma unroll
            for (int j = 0; j < 8; ++j) v[j] = xr[64 * j];
            if (F8_GU) { unsigned* o4 = (unsigned*)((unsigned char*)X2B + (size_t)m * D) + lane;
#pragma unroll
                for (int j = 0; j < 8; ++j) o4[64 * j] = pk4_fp8(v[j][0] * rstd, v[j][1] * rstd, v[j][2] * rstd, v[j][3] * rstd);
            } else { u32x2* o8 = (u32x2*)(X2B + (size_t)m * D) + lane;
#pragma unroll
                for (int j = 0; j < 8; ++j) { u32x2 o; o.x = cvt_pk_bf16(v[j][0] * rstd, v[j][1] * rstd); o.y = cvt_pk_bf16(v[j][2] * rstd, v[j][3] * rstd); o8[64 * j] = o; } }
        }
    }
}

__device__ __forceinline__ void moe_tile_table(const Args& a, volatile LAS unsigned* MISC) {
    if (threadIdx.x == 0) {
        const int* cnt = (const int*)(a.ws + WS_CTL) + CW_CNT; unsigned acc = 0;
        for (int e = 0; e < NE; ++e) { const int c = __hip_atomic_load(cnt + e, __ATOMIC_RELAXED, __HIP_MEMORY_SCOPE_AGENT); MISC[32 + e] = acc; MISC[96 + e] = (unsigned)c; acc += (unsigned)((c + 255) >> 8); }
        MISC[64] = acc;
    }
    __syncthreads();
    if (threadIdx.x < MAXTILES) {
        int e = 0;
#pragma unroll
        for (int k = 1; k < NE; ++k) e += (threadIdx.x >= MISC[32 + k]) ? 1 : 0;
        ((volatile LAS unsigned char*)MISC)[512 + threadIdx.x] = (unsigned char)e;
    }
    __syncthreads();
}
#ifndef WGM_GU
#define WGM_GU 4
#endif
#ifndef WGM_DN
#define WGM_DN 4
#endif
template <bool GU> struct SchedMoE {
    static constexpr bool GATHER = GU;
    const char* A; const char* Bt; const int* list; volatile LAS unsigned* MISC; int K, nM, nN, G, c;
    __device__ __forceinline__ bool next(int i, Unit& u) const {
        if (!static_order<GU ? WGM_GU : WGM_DN>(nM, nN, G, c, i, u.pm, u.pn, u.half)) return false;
        const int e = (int)((MISC[128 + (u.pm >> 2)] >> (8 * (u.pm & 3))) & 0xffu);
        u.e = __builtin_amdgcn_readfirstlane(e); return true;
    }
    __device__ __forceinline__ const char* a_base(const Unit& u) const { return GU ? A : A + (size_t)u.pm * BM * K * 2; }
    __device__ __forceinline__ const char* b_base(const Unit& u) const { return Bt + ((size_t)u.e * (GU ? 4096 : 2048) + (size_t)u.pn * BM) * K * 2; }
    __device__ __forceinline__ void a_voff(const Unit& u, unsigned (&v0)[2], unsigned (&v1)[2], const int (&sR)[2], const int (&sC)[2]) const {
        if (GU) {
            const int lt = u.pm - (int)MISC[32 + u.e], n = (int)MISC[96 + u.e]; const int* le = list + (size_t)u.e * T;
#pragma unroll
            for (int i = 0; i < 2; ++i) { const int r0 = lt * BM + sR[i], r1 = r0 + HALF; const int t0 = le[r0 < n ? r0 : 0], t1 = le[r1 < n ? r1 : 0];
                v0[i] = (unsigned)(t0 * K + sC[i]) * 2u; v1[i] = (unsigned)(t1 * K + sC[i]) * 2u; }
        } else {
#pragma unroll
            for (int i = 0; i < 2; ++i) { v0[i] = (unsigned)(sR[i] * K + sC[i]) * 2u; v1[i] = (unsigned)((sR[i] + HALF) * K + sC[i]) * 2u; }
        }
    }
};
struct EpiGU {
    static constexpr bool HAS_MID = false;
    const float* bg; const float* bu; bf16_t* act;
    template <bool HU> __device__ __forceinline__ void run(const f32x4 (&acc)[2][2][4][2], const Unit& u, int wr, int wc, int fr, int fq) const {
        const int row0 = opaque(u.pm * BM + wr * 64 + fr), f0 = u.pn * HALF + wc * 32 + 8 * fq;
        const f32x4 bg0 = *(const f32x4*)(bg + (size_t)u.e * D + f0), bg1 = *(const f32x4*)(bg + (size_t)u.e * D + f0 + 4);
        const f32x4 bu0 = *(const f32x4*)(bu + (size_t)u.e * D + f0) + 1.0f, bu1 = *(const f32x4*)(bu + (size_t)u.e * D + f0 + 4) + 1.0f;
        auto swiglu8 = [&](int ai, int m) -> u32x2 {
            f32x4 o[2];
#pragma unroll
            for (int nn = 0; nn < 2; ++nn) {
                f32x4 gv = acc[ai][0][m][nn] * (F8_GU ? 0.015625f : 1.0f) + (nn ? bg1 : bg0), uv1 = acc[ai][1][m][nn] * (F8_GU ? 0.015625f : 1.0f) + (nn ? bu1 : bu0);
                gv = __builtin_elementwise_min(gv, (f32x4){7.f, 7.f, 7.f, 7.f});
                uv1 = __builtin_elementwise_min(__builtin_elementwise_max(uv1, (f32x4){-6.f, -6.f, -6.f, -6.f}), (f32x4){8.f, 8.f, 8.f, 8.f});
                const f32x4 t = gv * (-1.702f * 1.4426950408889634f);
                f32x4 dn; dn[0] = __builtin_amdgcn_exp2f(t[0]); dn[1] = __builtin_amdgcn_exp2f(t[1]); dn[2] = __builtin_amdgcn_exp2f(t[2]); dn[3] = __builtin_amdgcn_exp2f(t[3]);
                dn = dn + 1.0f;
                f32x4 rc; rc[0] = __builtin_amdgcn_rcpf(dn[0]); rc[1] = __builtin_amdgcn_rcpf(dn[1]); rc[2] = __builtin_amdgcn_rcpf(dn[2]); rc[3] = __builtin_amdgcn_rcpf(dn[3]);
                o[nn] = (uv1 * gv) * rc;
            }
            u32x2 w8; w8.x = pk4_fp8(o[0][0], o[0][1], o[0][2], o[0][3]); w8.y = pk4_fp8(o[1][0], o[1][1], o[1][2], o[1][3]);
            return w8;
        };
        if constexpr (F8_DN && WIDE_ST && !HU) {
            const int odd = fq & 1;
#pragma unroll
            for (int ai = 0; ai < 2; ++ai)
#pragma unroll
                for (int mp = 0; mp < 4; mp += 2) {
                    const u32x2 wa = swiglu8(ai, mp), wb = swiglu8(ai, mp + 1);
                    *(u32x4*)((unsigned char*)act + (size_t)(row0 + ai * HALF + (mp + odd) * 16) * D + f0 - 8 * odd) = widen_rows(wa, wb);
                }
            return;
        }
#pragma unroll
        for (int ai = 0; ai < 2; ++ai) if (!HU || u.half != 2 - ai)
#pragma unroll
            for (int m = 0; m < 4; ++m) {
                f32x4 o[2];
#pragma unroll
                for (int nn = 0; nn < 2; ++nn) {
                    f32x4 gv = acc[ai][0][m][nn] * (F8_GU ? 0.015625f : 1.0f) + (nn ? bg1 : bg0), uv1 = acc[ai][1][m][nn] * (F8_GU ? 0.015625f : 1.0f) + (nn ? bu1 : bu0);
                    gv = __builtin_elementwise_min(gv, (f32x4){7.f, 7.f, 7.f, 7.f});
                    uv1 = __builtin_elementwise_min(__builtin_elementwise_max(uv1, (f32x4){-6.f, -6.f, -6.f, -6.f}), (f32x4){8.f, 8.f, 8.f, 8.f});
                    const f32x4 t = gv * (-1.702f * 1.4426950408889634f);
                    f32x4 dn; dn[0] = __builtin_amdgcn_exp2f(t[0]); dn[1] = __builtin_amdgcn_exp2f(t[1]); dn[2] = __builtin_amdgcn_exp2f(t[2]); dn[3] = __builtin_amdgcn_exp2f(t[3]);
                    dn = dn + 1.0f;
                    f32x4 rc; rc[0] = __builtin_amdgcn_rcpf(dn[0]); rc[1] = __builtin_amdgcn_rcpf(dn[1]); rc[2] = __builtin_amdgcn_rcpf(dn[2]); rc[3] = __builtin_amdgcn_rcpf(dn[3]);
                    o[nn] = (uv1 * gv) * rc;
                }
                if (F8_DN) { u32x2 w8; w8.x = pk4_fp8(o[0][0], o[0][1], o[0][2], o[0][3]); w8.y = pk4_fp8(o[1][0], o[1][1], o[1][2], o[1][3]);
                    *(u32x2*)((unsigned char*)act + (size_t)(row0 + ai * HALF + m * 16) * D + f0) = w8; }
                else { u32x4 w; w.x = cvt_pk_bf16(o[0][0], o[0][1]); w.y = cvt_pk_bf16(o[0][2], o[0][3]); w.z = cvt_pk_bf16(o[1][0], o[1][1]); w.w = cvt_pk_bf16(o[1][2], o[1][3]);
                    *(u32x4*)(act + (size_t)(row0 + ai * HALF + m * 16) * D + f0) = w; }
            }
    }
};
struct EpiDown {
    static constexpr bool HAS_MID = false;
    const float* bd; bf16_t* y;
    template <bool HU> __device__ __forceinline__ void run(const f32x4 (&acc)[2][2][4][2], const Unit& u, int wr, int wc, int fr, int fq) const {
        const int row0 = opaque(u.pm * BM + wr * 64 + fr), col0 = u.pn * BM + wc * 32 + 8 * fq;
        f32x4 b[2][2];
#pragma unroll
        for (int bj = 0; bj < 2; ++bj) { b[bj][0] = *(const f32x4*)(bd + (size_t)u.e * D + col0 + bj * HALF); b[bj][1] = *(const f32x4*)(bd + (size_t)u.e * D + col0 + bj * HALF + 4); }
        if constexpr (F8_Y && WIDE_ST && !HU) {
            const int odd = fq & 1;
#pragma unroll
            for (int ai = 0; ai < 2; ++ai)
#pragma unroll
                for (int mp = 0; mp < 4; mp += 2)
#pragma unroll
                    for (int bj = 0; bj < 2; ++bj) {
                        u32x2 w8[2];
#pragma unroll
                        for (int q = 0; q < 2; ++q) { const f32x4 v0 = acc[ai][bj][mp + q][0] * 0.015625f + b[bj][0], v1 = acc[ai][bj][mp + q][1] * 0.015625f + b[bj][1];
                            w8[q].x = pk4_fp8(v0[0], v0[1], v0[2], v0[3]); w8[q].y = pk4_fp8(v1[0], v1[1], v1[2], v1[3]); }
                        *(u32x4*)((unsigned char*)y + (size_t)(row0 + ai * HALF + (mp + odd) * 16) * D + col0 - 8 * odd + bj * HALF) = widen_rows(w8[0], w8[1]);
                    }
            return;
        }
#pragma unroll
        for (int ai = 0; ai < 2; ++ai) if (!HU || u.half != 2 - ai)
#pragma unroll
            for (int m = 0; m < 4; ++m) {
                bf16_t* op = y + (size_t)(row0 + ai * HALF + m * 16) * D + col0;
#pragma unroll
                for (int bj = 0; bj < 2; ++bj) {
                    const f32x4 v0 = acc[ai][bj][m][0] * (F8_DN ? 0.015625f : 1.0f) + b[bj][0], v1 = acc[ai][bj][m][1] * (F8_DN ? 0.015625f : 1.0f) + b[bj][1];
                    if (F8_Y) { u32x2 w8; w8.x = pk4_fp8(v0[0], v0[1], v0[2], v0[3]); w8.y = pk4_fp8(v1[0], v1[1], v1[2], v1[3]);
                        *(u32x2*)((unsigned char*)y + (size_t)(row0 + ai * HALF + m * 16) * D + col0 + bj * HALF) = w8; }
                    else { u32x4 w; w.x = cvt_pk_bf16(v0[0], v0[1]); w.y = cvt_pk_bf16(v0[2], v0[3]); w.z = cvt_pk_bf16(v1[0], v1[1]); w.w = cvt_pk_bf16(v1[2], v1[3]);
                        *(u32x4*)(op + bj * HALF) = w; }
                }
            }
    }
};
__device__ __forceinline__ void p11_final(const Args& a, volatile LAS unsigned* MISC, int vcu, int G) {
    const int lane = threadIdx.x & 63, wave = __builtin_amdgcn_readfirstlane(threadIdx.x >> 6);
    unsigned char* ws = a.ws;
    const float* X2 = (const float*)(ws + WS_X1); const bf16_t* Y = (const bf16_t*)(ws + WS_YMOE);
    const int* TE = (const int*)(ws + WS_TE); const int* TP = (const int*)(ws + WS_TP); const float* TW = (const float*)(ws + WS_TW);
    const int gw = vcu * NWAVES + wave, NGW = G * NWAVES;
    for (int tok = gw; tok < T; tok += NGW) {
        const int4 te = *(const int4*)(TE + tok * 4), tp = *(const int4*)(TP + tok * 4); const float4 tw = *(const float4*)(TW + tok * 4);
        const size_t r0 = (size_t)MISC[32 + te.x] * BM + tp.x, r1 = (size_t)MISC[32 + te.y] * BM + tp.y, r2 = (size_t)MISC[32 + te.z] * BM + tp.z, r3 = (size_t)MISC[32 + te.w] * BM + tp.w;
        f32x4 v[4][2]; float ss = 0.f;
#pragma unroll
        for (int jj = 0; jj < 4; ++jj) {
            const int c = 8 * (lane + 64 * jj);
            const f32x4 x0 = *(const f32x4*)(X2 + (size_t)tok * D + c), x1 = *(const f32x4*)(X2 + (size_t)tok * D + c + 4);
            float o[8];
            if (F8_Y) {
                const unsigned char* Y8 = (const unsigned char*)Y;
                const u32x2 y0 = *(const u32x2*)(Y8 + r0 * D + c), y1 = *(const u32x2*)(Y8 + r1 * D + c), y2 = *(const u32x2*)(Y8 + r2 * D + c), y3 = *(const u32x2*)(Y8 + r3 * D + c);
#pragma unroll
                for (int e = 0; e < 2; ++e)
#pragma unroll
                    for (int hw = 0; hw < 2; ++hw) {
                        const f32x2 a0 = hw ? __builtin_amdgcn_cvt_pk_f32_fp8((int)y0[e], true) : __builtin_amdgcn_cvt_pk_f32_fp8((int)y0[e], false), a1 = hw ? __builtin_amdgcn_cvt_pk_f32_fp8((int)y1[e], true) : __builtin_amdgcn_cvt_pk_f32_fp8((int)y1[e], false);
                        const f32x2 a2 = hw ? __builtin_amdgcn_cvt_pk_f32_fp8((int)y2[e], true) : __builtin_amdgcn_cvt_pk_f32_fp8((int)y2[e], false), a3 = hw ? __builtin_amdgcn_cvt_pk_f32_fp8((int)y3[e], true) : __builtin_amdgcn_cvt_pk_f32_fp8((int)y3[e], false);
                        o[4 * e + 2 * hw] = tw.x * a0[0] + tw.y * a1[0] + tw.z * a2[0] + tw.w * a3[0]; o[4 * e + 2 * hw + 1] = tw.x * a0[1] + tw.y * a1[1] + tw.z * a2[1] + tw.w * a3[1];
                    }
            } else {
            const u32x4 y0 = *(const u32x4*)(Y + r0 * D + c), y1 = *(const u32x4*)(Y + r1 * D + c), y2 = *(const u32x4*)(Y + r2 * D + c), y3 = *(const u32x4*)(Y + r3 * D + c);
#pragma unroll
            for (int e = 0; e < 4; ++e) {
                o[2 * e] = tw.x * __uint_as_float(y0[e] << 16) + tw.y * __uint_as_float(y1[e] << 16) + tw.z * __uint_as_float(y2[e] << 16) + tw.w * __uint_as_float(y3[e] << 16);
                o[2 * e + 1] = tw.x * __uint_as_float(y0[e] & 0xffff0000u) + tw.y * __uint_as_float(y1[e] & 0xffff0000u) + tw.z * __uint_as_float(y2[e] & 0xffff0000u) + tw.w * __uint_as_float(y3[e] & 0xffff0000u);
            }
            }
            v[jj][0] = x0 + (f32x4){o[0], o[1], o[2], o[3]}; v[jj][1] = x1 + (f32x4){o[4], o[5], o[6], o[7]};
#pragma unroll
            for (int h = 0; h < 2; ++h) ss += (v[jj][h][0] * v[jj][h][0] + v[jj][h][1] * v[jj][h][1]) + (v[jj][h][2] * v[jj][h][2] + v[jj][h][3] * v[jj][h][3]);
        }
        const float rstd = 1.0f / sqrtf(wave_sum(ss) * (1.0f / D) + EPS);
#pragma unroll
        for (int jj = 0; jj < 4; ++jj) {
            const int c = 8 * (lane + 64 * jj);
            const f32x4 g0 = *(const f32x4*)(a.in[23] + c), g1 = *(const f32x4*)(a.in[23] + c + 4);
            *(f32x4*)(a.out + (size_t)tok * D + c) = v[jj][0] * rstd * g0; *(f32x4*)(a.out + (size_t)tok * D + c + 4) = v[jj][1] * rstd * g1;
        }
    }
}
#ifndef STEAL_P1
#define STEAL_P1 8
#endif
#ifndef STEAL_P5
#define STEAL_P5 12
#endif
#ifndef HD3
#define HD3 2
#endif
#ifndef HD4
#define HD4 2
#endif
#ifndef HD7
#define HD7 2
#endif
#define DQ_P3 (1024 * STEAL_P1)
#define DQ_P4 (DQ_P3 + 2048 * HD3)
#define DQ_P5 (DQ_P4 + 2048 * HD4)
#define DQ_P7 (DQ_P5 + 896 * STEAL_P5)
#define DQ_P9 (DQ_P7 + 2048 * HD7)
static_assert(DQ_P9 <= NE * 1024 && (NE * 1024 - DQ_P9) % 4 == 0, "w_down queue");
#define HOST_DOWN(first, n) do { if (G == 256) convert_down_static<(n)>(args, lds, (first), bx * NWAVES + (tid >> 6), 2048); } while (0)
__global__ void __launch_bounds__(NTHREADS, 2) mk_fwd(Args args) {
    extern __shared__ __attribute__((aligned(16))) unsigned char lds_raw[];
    LAS unsigned char* lds = (LAS unsigned char*)lds_raw;
    volatile LAS unsigned* MISC = (volatile LAS unsigned*)(lds + MISC_OFF);
    const int tid = threadIdx.x;
    const int G = gridDim.x; const int bx = blockIdx.x; const int vcu = (G % 8 == 0) ? (bx % 8) * (G / 8) + bx / 8 : bx;
    unsigned char* ws = args.ws;
    if (tid < 256) MISC[tid] = 0u;
    __syncthreads();
    const int lo = args.ph_lo, hi = args.ph_hi;
    const bool use_bar = (hi - lo) > 1;
    XcdBarrier bar; bar.bar = (unsigned*)(ws + WS_CTL); bar.x = 0; bar.st = nullptr;
    if (use_bar) bar = xcd_barrier_post((unsigned*)(ws + WS_CTL), MISC + 8);
#ifndef HOST_SEL
#define HOST_SEL 0
#endif
    const bool HOST_FIRST = HOST_SEL == 0 ? (bx & 1) != 0 : ((bx >> 3) & 1) != 0;
#define IN(k) (lo <= (k) && (k) < hi)
#define SEAM(k) do { if (IN(k) && IN((k) + 1)) xcd_barrier(bar); } while (0)

    if (IN(0)) { p0_prologue(args, lds, vcu, G); __syncthreads(); }
    SEAM(0);
    if (IN(1)) {
        constexpr int KB = F8_P1 ? D / 2 : D;
        SchedPlain S{(const char*)(ws + WS_XB), (const char*)(ws + WS_WIN_T), KB, T / BM, DIN / BM, G, bx};
        EpiProj E{(bf16_t*)(ws + WS_PROJB), (bf16_t*)(ws + WS_GATES), (const float*)(ws + WS_ROPE)};
        gemm_phase<EpiProj, SchedPlain, 0, F8_P1 != 0>(lds, KB, S, E);
        if (G == 256 && (XCD_TAIL ? (bx & 7) >= 4 : bx >= 128)) convert_down_static<STEAL_P1>(args, lds, 0, (XCD_TAIL ? (bx >> 3) * 4 + (bx & 7) - 4 : bx - 128) * NWAVES + (tid >> 6), 1024);
    }
    SEAM(1);
    if (IN(2)) { p2_attention(args, lds, vcu, G); __syncthreads(); }
    SEAM(2);
    if (IN(3)) {
        constexpr int KB3 = F8_P3 ? D / 2 : D;
        SchedPlain S{(const char*)(ws + WS_Y), (const char*)(ws + WS_WOA_T), KB3, T / BM, D / BM, G, bx};
        EpiMerge E{(const bf16_t*)(ws + WS_GATES), (bf16_t*)(ws + WS_MERGED)};
        if (HOST_FIRST) { convert_gu_chunk<DEFER_N3>(args, lds, GU_P0_TILES); HOST_DOWN(DQ_P3, HD3); __syncthreads(); }
        gemm_phase<EpiMerge, SchedPlain, 0, F8_P3 != 0>(lds, KB3, S, E);
        if (!HOST_FIRST) { convert_gu_chunk<DEFER_N3>(args, lds, GU_P0_TILES); HOST_DOWN(DQ_P3, HD3); }
    }
    SEAM(3);
    if (IN(4)) {
        constexpr int KB4 = F8_P4 ? D / 2 : D;
        SchedPlain S{(const char*)(ws + WS_MERGED), (const char*)(ws + WS_WOUT_T), KB4, T / BM, D / BM, G, bx};
        EpiResid<true> E{args.in[0], (float*)(ws + WS_X1), (bf16_t*)(ws + WS_XB), (float*)(ws + WS_SS1), F8_P4 ? 1.0f / 512.0f : 1.0f};
        if (HOST_FIRST) { convert_gu_chunk<DEFER_N4>(args, lds, GU_P0_TILES + 2048 * DEFER_N3); HOST_DOWN(DQ_P4, HD4); __syncthreads(); }
        gemm_phase<EpiResid<true>, SchedPlain, 0, F8_P4 != 0>(lds, KB4, S, E);
        if (!HOST_FIRST) { convert_gu_chunk<DEFER_N4>(args, lds, GU_P0_TILES + 2048 * DEFER_N3); HOST_DOWN(DQ_P4, HD4); }
    }
    SEAM(4);
    if (IN(5)) {
        const int r5 = (XCD_TAIL && G == 256) ? (bx & 7) * 32 + (bx >> 3) : bx;
        SchedCross S{(const char*)(ws + WS_XB), (const char*)(ws + WS_WCQ_T), (const char*)(ws + WS_MEMB), (const char*)(ws + WS_WCKV_T), D, G, r5};
        EpiCross E{(const float*)(ws + WS_SS1), (bf16_t*)(ws + WS_QC), (bf16_t*)(ws + WS_KVC)};
        gemm_phase<EpiCross, SchedCross>(lds, D, S, E);
        if (G == 256 && r5 >= 144) convert_down_static<STEAL_P5>(args, lds, DQ_P5, (r5 - 144) * NWAVES + (tid >> 6), 896);
    }
    SEAM(5);
    if (IN(6)) { p6_cross_attention(args, lds, vcu, G); __syncthreads(); }
    SEAM(6);
    if (IN(7)) {
        SchedPlain S{(const char*)(ws + WS_OC), (const char*)(ws + WS_WCO_T), 512, T / BM, D / BM, G, bx};
        EpiResid<false> E{(const float*)(ws + WS_X1), (float*)(ws + WS_X1), nullptr, (float*)(ws + WS_SS2), 1.0f};
        if (HOST_FIRST) { convert_gu_chunk<DEFER_N7>(args, lds, GU_P0_TILES + 2048 * (DEFER_N3 + DEFER_N4)); HOST_DOWN(DQ_P7, HD7); __syncthreads(); }
        gemm_phase<EpiResid<false>, SchedPlain>(lds, 512, S, E);
        if (!HOST_FIRST) { convert_gu_chunk<DEFER_N7>(args, lds, GU_P0_TILES + 2048 * (DEFER_N3 + DEFER_N4)); HOST_DOWN(DQ_P7, HD7); }
    }
    SEAM(7);
    if (IN(8)) { p8_router(args, lds, vcu, G); }
    SEAM(8);
    if (IN(9)) {
        moe_tile_table(args, MISC);
        constexpr int KB = F8_GU ? D / 2 : D;
        SchedMoE<true> S{(const char*)(ws + WS_XB), (const char*)(ws + WS_WGU_T), (const int*)(ws + WS_LIST), MISC, KB, (int)MISC[64], 16, G, bx};
        EpiGU E{args.in[18], args.in[20], (bf16_t*)(ws + WS_ACT)};
        gemm_phase<EpiGU, SchedMoE<true>, 0, F8_GU != 0>(lds, KB, S, E);
        convert_down_drain(args, lds, G == 256 ? DQ_P9 : 0);
    }
    SEAM(9);
    if (IN(10)) {
        moe_tile_table(args, MISC);
        constexpr int KB = F8_DN ? D / 2 : D;
        SchedMoE<false> S{(const char*)(ws + WS_ACT), (const char*)(ws + WS_WD_T), nullptr, MISC, KB, (int)MISC[64], 8, G, bx};
        EpiDown E{args.in[22], (bf16_t*)(ws + WS_YMOE)};
        gemm_phase<EpiDown, SchedMoE<false>, 0, F8_DN != 0>(lds, KB, S, E);
    }
    SEAM(10);
    if (IN(11)) { moe_tile_table(args, MISC); p11_final(args, MISC, vcu, G); }
#undef IN
#undef SEAM
}

extern "C" void kernel_launch(void* const* d_in, const int* in_sizes, int n_in, void* d_out, int out_size, void* d_ws, size_t ws_size, hipStream_t stream) {
    static int grid = 0;
    if (grid == 0) {
        int dev = 0, cus = 0;
        if (hipGetDevice(&dev) != hipSuccess || hipDeviceGetAttribute(&cus, hipDeviceAttributeMultiprocessorCount, dev) != hipSuccess) { grid = -1; return; }
        if (hipFuncSetAttribute((const void*)mk_fwd, hipFuncAttributeMaxDynamicSharedMemorySize, LDS_BYTES) != hipSuccess) { grid = -1; return; }
        int per_cu = 0;
        if (hipOccupancyMaxActiveBlocksPerMultiprocessor(&per_cu, (const void*)mk_fwd, NTHREADS, LDS_BYTES) != hipSuccess || per_cu < 1) { grid = -1; return; }
        (void)hipGetLastError();
        grid = cus;
    }
    if (grid < 0 || ws_size < WS_END) return;
    float* out = (float*)d_out;
    unsigned char* ws = (unsigned char*)d_ws;
    (void)hipMemsetAsync(ws + WS_CTL, 0, WS_ZERO_BYTES, stream);
    Args a{};
    for (int i = 0; i < 24; ++i) a.in[i] = (const float*)d_in[i];
    a.out = out; a.ws = ws;
    a.ph_lo = 0; a.ph_hi = 12;
    hipLaunchKernelGGL(mk_fwd, dim3(grid), dim3(NTHREADS), LDS_BYTES, stream, a);
}
```
